# Optimizing an MI355X kernel written in HIP

```python
import jax, jax.numpy as jnp
from jax import lax
import numpy as np

D_MODEL = 1024
BATCH = 2
SEQ = 16384
DEPTH = 1
DEC_BATCH = 8
DEC_SEQ = 2048
PAST_LEN = 128

MIX_WIDTH = D_MODEL
FNET_WIDTH = D_MODEL // 2
FNET_GROUPS = 4
FNET_GROUP_DIM = FNET_WIDTH // FNET_GROUPS
RET_WIDTH = MIX_WIDTH - FNET_WIDTH
RET_HEADS = 4
RET_HEAD_DIM = RET_WIDTH // RET_HEADS
D_FF = 4 * D_MODEL
CHUNK = 128
ROPE_BASE = 10000.0
EPS = 1e-6
N_MOD = 6
IN_WIDTH = FNET_WIDTH + 4 * RET_WIDTH
SPLITS = (FNET_WIDTH, FNET_WIDTH + RET_WIDTH, FNET_WIDTH + 2 * RET_WIDTH, FNET_WIDTH + 3 * RET_WIDTH)
DECAY_OFFSET_FWD = 0.0
DECAY_OFFSET_BWD = 0.5

kernel_name = "hymba_fnet_retnet_adaln_encoder"


def rmsnorm(x, g):
    xf = x.astype(jnp.float32)
    y = xf * lax.rsqrt(jnp.mean(xf * xf, axis=-1, keepdims=True) + EPS)
    return (y * g.astype(jnp.float32)).astype(x.dtype)


def modulate(h, shift, scale):
    return h * (1.0 + scale[:, None, :]) + shift[:, None, :]


def rotary(x):
    S = x.shape[1]
    half = x.shape[-1] // 2
    inv = ROPE_BASE ** (-jnp.arange(half, dtype=jnp.float32) / half)
    ang = jnp.arange(S, dtype=jnp.float32)[:, None] * inv[None, :]
    cos = jnp.cos(ang)[None, :, None, :]
    sin = jnp.sin(ang)[None, :, None, :]
    xf = x.astype(jnp.float32)
    x1, x2 = xf[..., :half], xf[..., half:]
    return jnp.concatenate([x1 * cos - x2 * sin, x1 * sin + x2 * cos], axis=-1)


def log_gammas(offset):
    return jnp.log1p(-jnp.exp2(-5.0 - offset - jnp.arange(RET_HEADS, dtype=jnp.float32)))


def retention_chunkwise(q, k, v, log_g, strict):
    B, S, H, Dh = q.shape
    N = S // CHUNK
    qc = q.reshape(B, N, CHUNK, H, Dh)
    kc = k.reshape(B, N, CHUNK, H, Dh)
    vc = v.reshape(B, N, CHUNK, H, Dh)
    pos = jnp.arange(CHUNK, dtype=jnp.float32)
    diff = pos[:, None] - pos[None, :]
    mask = (diff > 0) if strict else (diff >= 0)
    decay = jnp.where(mask[None], jnp.exp(log_g[:, None, None] * jnp.maximum(diff, 0.0)[None]), 0.0)
    scores = jnp.einsum('bnihd,bnjhd->bnhij', qc, kc) * decay[None, None]
    inner = jnp.einsum('bnhij,bnjhe->bnihe', scores, vc)
    zeta = jnp.exp(log_g[:, None] * (CHUNK - 1.0 - pos)[None])
    kv = jnp.einsum('bnjhd,hj,bnjhe->bnhde', kc, zeta, vc)
    chunk_decay = jnp.exp(log_g * CHUNK)[None, :, None, None]

    def step(state, kv_n):
        return state * chunk_decay + kv_n, state

    _, prev = lax.scan(step, jnp.zeros((B, H, Dh, Dh), q.dtype), jnp.moveaxis(kv, 1, 0))
    prev = jnp.moveaxis(prev, 0, 1)
    xi = jnp.exp(log_g[:, None] * (pos + 1.0)[None])
    cross = jnp.einsum('bnihd,hi,bnhde->bnihe', qc, xi, prev)
    return (inner + cross).reshape(B, S, H, Dh)


def hybrid_mixer(h, w_in, w_fnet, w_out):
    B, S, _ = h.shape
    proj = h @ w_in
    u, q, k, v, g = jnp.split(proj, SPLITS, axis=-1)
    ug = u.reshape(B, S, FNET_GROUPS, FNET_GROUP_DIM).astype(jnp.float32)
    f = jnp.fft.fft2(ug, axes=(1, 3), norm='ortho').real
    f = jnp.einsum('bsgc,gcd->bsgd', f.astype(h.dtype), w_fnet).reshape(B, S, FNET_WIDTH)
    q = rotary(q.reshape(B, S, RET_HEADS, RET_HEAD_DIM))
    k = rotary(k.reshape(B, S, RET_HEADS, RET_HEAD_DIM)) * (RET_HEAD_DIM ** -0.5)
    v = v.reshape(B, S, RET_HEADS, RET_HEAD_DIM).astype(jnp.float32)
    fwd = retention_chunkwise(q, k, v, log_gammas(DECAY_OFFSET_FWD), False)
    bwd = jnp.flip(retention_chunkwise(jnp.flip(q, 1), jnp.flip(k, 1), jnp.flip(v, 1),
                                       log_gammas(DECAY_OFFSET_BWD), True), axis=1)
    r = fwd + bwd
    r = r * lax.rsqrt(jnp.mean(r * r, axis=-1, keepdims=True) + EPS)
    r = r.reshape(B, S, RET_WIDTH).astype(h.dtype) * jax.nn.silu(g)
    return jnp.concatenate([f, r], axis=-1) @ w_out


def encoder_layer(x, c, ada_w, ada_b, norm_mix, w_in, w_fnet, w_out, norm_mlp, w_mlp_in, w_mlp_out):
    mod = jax.nn.silu(c) @ ada_w + ada_b
    sh1, sc1, gt1, sh2, sc2, gt2 = jnp.split(mod, N_MOD, axis=-1)
    h = modulate(rmsnorm(x, norm_mix), sh1, sc1)
    x = x + gt1[:, None, :] * hybrid_mixer(h, w_in, w_fnet, w_out)
    h = modulate(rmsnorm(x, norm_mlp), sh2, sc2)
    x = x + gt2[:, None, :] * (jnp.square(jax.nn.relu(h @ w_mlp_in)) @ w_mlp_out)
    return x


def run_trunk(x, c, ada_w, ada_b, norm_mix, w_in, w_fnet, w_out, norm_mlp, w_mlp_in, w_mlp_out, norm_final):
    for l in range(DEPTH):
        x = encoder_layer(x, c, ada_w[l], ada_b[l], norm_mix[l], w_in[l], w_fnet[l], w_out[l],
                          norm_mlp[l], w_mlp_in[l], w_mlp_out[l])
    return rmsnorm(x, norm_final)


def setup_inputs(seed: int = 0) -> dict:
    key = jax.random.key(seed)
    ks = jax.random.split(key, 16)
    f32 = jnp.float32
    nrm = lambda k, shape, s: jax.random.normal(k, shape, f32) * s
    return {
        "x_prompt": nrm(ks[0], (BATCH, SEQ, D_MODEL), 1.0),
        "x_sample": nrm(ks[1], (DEC_BATCH, DEC_SEQ, D_MODEL), 1.0),
        "c_prompt": nrm(ks[2], (BATCH, D_MODEL), 1.0),
        "c_sample": nrm(ks[3], (DEC_BATCH, D_MODEL), 1.0),
        "ada_w": nrm(ks[4], (DEPTH, D_MODEL, N_MOD * D_MODEL), 0.5 * D_MODEL ** -0.5),
        "ada_b": nrm(ks[5], (DEPTH, N_MOD * D_MODEL), 0.02),
        "norm_mix": 1.0 + nrm(ks[6], (DEPTH, D_MODEL), 0.02),
        "w_in": nrm(ks[7], (DEPTH, D_MODEL, IN_WIDTH), D_MODEL ** -0.5),
        "w_fnet": nrm(ks[8], (DEPTH, FNET_GROUPS, FNET_GROUP_DIM, FNET_GROUP_DIM), FNET_GROUP_DIM ** -0.5),
        "w_out": nrm(ks[9], (DEPTH, MIX_WIDTH, D_MODEL), MIX_WIDTH ** -0.5),
        "norm_mlp": 1.0 + nrm(ks[10], (DEPTH, D_MODEL), 0.02),
        "w_mlp_in": nrm(ks[11], (DEPTH, D_MODEL, D_FF), D_MODEL ** -0.5),
        "w_mlp_out": nrm(ks[12], (DEPTH, D_FF, D_MODEL), D_FF ** -0.5),
        "norm_final": 1.0 + nrm(ks[13], (D_MODEL,), 0.02),
    }


def reference(x_prompt, x_sample, c_prompt, c_sample, ada_w, ada_b, norm_mix, w_in, w_fnet, w_out,
              norm_mlp, w_mlp_in, w_mlp_out, norm_final):
    y_prompt = run_trunk(x_prompt, c_prompt, ada_w, ada_b, norm_mix, w_in, w_fnet, w_out,
                         norm_mlp, w_mlp_in, w_mlp_out, norm_final)
    y_sample = run_trunk(x_sample, c_sample, ada_w, ada_b, norm_mix, w_in, w_fnet, w_out,
                         norm_mlp, w_mlp_in, w_mlp_out, norm_final)
    return (y_prompt, y_sample)
```

```cpp
#include <hip/hip_runtime.h>
#include <hip/hip_cooperative_groups.h>
#include <cstdio>
namespace cg = cooperative_groups;

#ifndef DBG
#define DBG 0
#endif
#ifndef MK_COOP
#define MK_COOP 1
#endif

#define LAS __attribute__((address_space(3)))
typedef LAS char lchar;
typedef unsigned short bf16_t;
typedef short bf16x8 __attribute__((ext_vector_type(8)));
typedef short s16x4 __attribute__((ext_vector_type(4)));
typedef float f32x4 __attribute__((ext_vector_type(4)));
typedef unsigned u32x2 __attribute__((ext_vector_type(2)));
typedef float f32x2 __attribute__((ext_vector_type(2)));
typedef unsigned u32x4 __attribute__((ext_vector_type(4)));

constexpr int NTOK = 49152, DM = 1024, INW = 2560, DFF = 4096;
constexpr int PROWS = 32768;
constexpr int NB = 10;
constexpr int LDS_BYTES = 4 * 32768 + 4096;

constexpr size_t OFF_PROJ = 0;
constexpr size_t OFF_PREV = (size_t)NTOK * INW * 2;
constexpr size_t OFF_H2   = (size_t)NTOK * DFF * 2;
constexpr size_t OFF_WIN  = OFF_H2 + (size_t)NTOK * DM * 2;
constexpr size_t OFF_WOUT = OFF_WIN + (size_t)INW * DM * 2;
constexpr size_t OFF_W1   = OFF_WOUT + (size_t)DM * DM * 2;
constexpr size_t OFF_W2   = OFF_W1 + (size_t)DFF * DM * 2;
constexpr size_t OFF_MOD  = OFF_W2 + (size_t)DFF * DM * 2;
constexpr size_t OFF_ROT  = OFF_MOD + (size_t)NB * 6144 * 4;
constexpr size_t OFF_FTAB = OFF_ROT + 2 * 128 * 64 * 8;
constexpr size_t OFF_MTAB = OFF_FTAB + 5 * 32768;
constexpr size_t OFF_TWP  = OFF_MTAB + 8 * 32768;
constexpr size_t OFF_TWS  = OFF_TWP + 16384 * 8;
constexpr size_t OFF_GPOW = OFF_TWS + 2048 * 8;
constexpr size_t OFF_BAR  = (OFF_GPOW + 2 * 4 * 132 * 4 + 255) / 256 * 256;
constexpr size_t OFF_SSQ  = OFF_BAR + 3456 * 4;
constexpr size_t OFF_BIAS2 = OFF_SSQ + (size_t)NTOK * 16 * 4;
constexpr size_t WS_END   = OFF_BIAS2 + (size_t)NB * DFF * 4;
static_assert(WS_END <= (size_t)536870912, "workspace");
constexpr size_t OUT_H   = 0;
constexpr size_t OUT_KV  = (size_t)NTOK * DM * 2;

struct Params {
  const float *x_prompt, *x_sample, *c_prompt, *c_sample, *ada_w, *ada_b, *norm_mix, *w_in, *w_fnet, *w_out,
      *norm_mlp, *w_mlp_in, *w_mlp_out, *norm_final;
  float* out;
  char* ws;
};

__device__ __forceinline__ unsigned pack_bf16(float lo, float hi) {
  unsigned r; asm("v_cvt_pk_bf16_f32 %0, %1, %2" : "=v"(r) : "v"(lo), "v"(hi)); return r;
}
__device__ __forceinline__ float bf_lo(unsigned u) { return __uint_as_float(u << 16); }
__device__ __forceinline__ float bf_hi(unsigned u) { return __uint_as_float(u & 0xffff0000u); }
__device__ __forceinline__ int row_batch(int R) { return R < PROWS ? (R >> 14) : 2 + ((R - PROWS) >> 11); }
__device__ __forceinline__ int row_pos(int R) { return R < PROWS ? (R & 16383) : ((R - PROWS) & 2047); }
__device__ __forceinline__ const float* xrow(const Params& p, int R) {
  return R < PROWS ? p.x_prompt + (size_t)R * DM : p.x_sample + (size_t)(R - PROWS) * DM;
}
__device__ __forceinline__ float silu_f(float v) { return v / (1.f + __expf(-v)); }
#define WAIT_V0() asm volatile("s_waitcnt vmcnt(0)" ::: "memory")

__device__ void sincos_d(double x, double& s, double& c) {
  double q = rint(x * 0.63661977236758134308);
  double r = fma(-q, 1.57079632679489655800e+00, x);
  r = fma(-q, 6.12323399573676603587e-17, r);
  int qi = (int)(((long long)q) & 3);
  double r2 = r * r;
  double sp = r * (1.0 + r2 * (-1.0 / 6 + r2 * (1.0 / 120 + r2 * (-1.0 / 5040 + r2 * (1.0 / 362880 + r2 * (-1.0 / 39916800 + r2 * (1.0 / 6227020800.0)))))));
  double cp = 1.0 + r2 * (-0.5 + r2 * (1.0 / 24 + r2 * (-1.0 / 720 + r2 * (1.0 / 40320 + r2 * (-1.0 / 3628800 + r2 * (1.0 / 479001600.0 + r2 * (-1.0 / 87178291200.0)))))));
  if (qi == 0) { s = sp; c = cp; } else if (qi == 1) { s = cp; c = -sp; } else if (qi == 2) { s = -sp; c = -cp; } else { s = -cp; c = sp; }
}

__device__ __forceinline__ int lds_byte2(int r, int c) {
  int st = (r >> 4) * 2 + (c >> 5), ob = (r & 15) * 64 + (c & 31) * 2;
  return st * 1024 + (ob ^ (((ob >> 9) & 1) << 5));
}
__device__ __forceinline__ void stage_rc2(int b, int& R, int& C) {
  int st = b >> 10, sb = b & 1023, swz = sb ^ (((sb >> 9) & 1) << 5);
  R = (st >> 1) * 16 + swz / 64;
  C = (st & 1) * 32 + (swz % 64) / 2;
}
__device__ __forceinline__ void unit_map(int u, int nM, int nN, int& pm, int& pn) {
  int nwg = nM * nN, wgid = u;
  { int q = nwg / 8, r = nwg % 8, xcd = wgid % 8, off = wgid / 8; wgid = (xcd < r ? xcd * (q + 1) : r * (q + 1) + (xcd - r) * q) + off; }
  int nig = 8 * nN, gid = wgid / nig, fm = gid * 8, gsz = min(nM - fm, 8);
  pm = fm + ((wgid % nig) % gsz); pn = (wgid % nig) / gsz;
}

template <class Epi>
__device__ __forceinline__ void gemm_unit(lchar* shm, const bf16_t* __restrict__ A, int lda, int ksplit, int kjump,
                                          const bf16_t* __restrict__ Bt, int K, int pm, int pn, const Epi& epi) {
  constexpr int TILE_B = 256 * 64 * 2, STAGE_B = 2 * TILE_B;
  const int tid = threadIdx.x, wid = tid >> 6, lane = tid & 63, wr = wid >> 2, wc = wid & 3, fr = lane & 15, fq = lane >> 4;
  const bf16_t* Ab = A + (size_t)pm * 256 * lda;
  const bf16_t* Bb = Bt + (size_t)pn * 256 * K;
  int offA[4], offB[4];
#pragma unroll
  for (int i = 0; i < 4; ++i) { int r, c; stage_rc2(wid * 1024 + i * 8192 + lane * 16, r, c); offA[i] = r * lda + c; offB[i] = r * K + c; }
  f32x4 acc[8][4];
#pragma unroll
  for (int m = 0; m < 8; ++m)
#pragma unroll
    for (int n = 0; n < 4; ++n) acc[m][n] = (f32x4){0.f, 0.f, 0.f, 0.f};
  const int nt = K / 64;
#define G_STAGE(buf, kt) do { const int kc_ = (kt) * 64; const int ka_ = kc_ + (kc_ >= ksplit ? kjump : 0);            \
    _Pragma("unroll") for (int i = 0; i < 4; ++i) {                                                                    \
      __builtin_amdgcn_global_load_lds((const unsigned*)(Ab + offA[i] + ka_), (LAS unsigned*)(shm + (buf) * STAGE_B + wid * 1024 + i * 8192), 16, 0, 0); \
      __builtin_amdgcn_global_load_lds((const unsigned*)(Bb + offB[i] + kc_), (LAS unsigned*)(shm + (buf) * STAGE_B + TILE_B + wid * 1024 + i * 8192), 16, 0, 0); } } while (0)
  G_STAGE(0, 0); WAIT_V0(); __syncthreads();
  for (int t = 0; t < nt; ++t) {
    const int cur = t & 1;
    if (t + 1 < nt) G_STAGE(cur ^ 1, t + 1);
#pragma unroll
    for (int ks = 0; ks < 2; ++ks) {
      bf16x8 At[8], Bf[4];
#pragma unroll
      for (int m = 0; m < 8; ++m) At[m] = *(const LAS bf16x8*)(shm + cur * STAGE_B + lds_byte2(wr * 128 + m * 16 + fr, ks * 32 + fq * 8));
#pragma unroll
      for (int n = 0; n < 4; ++n) Bf[n] = *(const LAS bf16x8*)(shm + cur * STAGE_B + TILE_B + lds_byte2(wc * 64 + n * 16 + fr, ks * 32 + fq * 8));
#pragma unroll
      for (int m = 0; m < 8; ++m)
#pragma unroll
        for (int n = 0; n < 4; ++n) acc[m][n] = __builtin_amdgcn_mfma_f32_16x16x32_bf16(Bf[n], At[m], acc[m][n], 0, 0, 0);
      __builtin_amdgcn_sched_barrier(0);
    }
    WAIT_V0(); __syncthreads();
  }
#undef G_STAGE
  epi(acc, pm * 256 + wr * 128 + fr, pn, wc, fq);
}

struct EpiInProj {
  const Params& p;
  __device__ __forceinline__ void operator()(f32x4 (&acc)[8][4], int row0, int pn, int wc, int fq) const {
    bf16_t* proj = (bf16_t*)(p.ws + OFF_PROJ);
    const float2* rotA = (const float2*)(p.ws + OFF_ROT);
    const float2* rotB = rotA + 128 * 64;
    const int kind = pn >> 1;
    const int cbase = pn * 256 + (wc >> 1) * 128 + (wc & 1) * 32 + fq * 4;
#pragma unroll
    for (int m = 0; m < 8; ++m) {
      const int R = row0 + 16 * m;
      bf16_t* rowp = proj + (size_t)R * INW + cbase;
      if (kind == 1 || kind == 2) {
        const int pos = row_pos(R);
        const float sc = (kind == 2) ? 0.08838834764831845f : 1.f;
#pragma unroll
        for (int n = 0; n < 2; ++n) {
          const int j = (wc & 1) * 32 + n * 16 + fq * 4;
          f32x4 o1, o2;
#pragma unroll
          for (int r = 0; r < 4; ++r) {
            const float2 a = rotA[(pos >> 7) * 64 + j + r], b = rotB[(pos & 127) * 64 + j + r];
            const float c = a.x * b.x - a.y * b.y, s = a.y * b.x + a.x * b.y;
            const float x1 = acc[m][n][r], x2 = acc[m][n + 2][r];
            o1[r] = (x1 * c - x2 * s) * sc; o2[r] = (x1 * s + x2 * c) * sc;
          }
          *(u32x2*)(rowp + n * 16) = (u32x2){pack_bf16(o1[0], o1[1]), pack_bf16(o1[2], o1[3])};
          *(u32x2*)(rowp + 64 + n * 16) = (u32x2){pack_bf16(o2[0], o2[1]), pack_bf16(o2[2], o2[3])};
        }
      } else {
#pragma unroll
        for (int n = 0; n < 4; ++n) {
          f32x4 v = acc[m][n];
          if (kind == 4) { v[0] = silu_f(v[0]); v[1] = silu_f(v[1]); v[2] = silu_f(v[2]); v[3] = silu_f(v[3]); }
          *(u32x2*)(rowp + (n >> 1) * 64 + (n & 1) * 16) = (u32x2){pack_bf16(v[0], v[1]), pack_bf16(v[2], v[3])};
        }
      }
    }
  }
};
struct EpiOutProj {
  const Params& p;
  __device__ __forceinline__ void operator()(f32x4 (&acc)[8][4], int row0, int pn, int wc, int fq) const {
    const float* mod = (const float*)(p.ws + OFF_MOD);
    const int c0 = pn * 256 + wc * 64 + fq * 4;
    const float* gt = mod + row_batch(row0) * 6144 + 2048 + c0;
    f32x4 g[4];
#pragma unroll
    for (int n = 0; n < 4; ++n) g[n] = *(const f32x4*)(gt + n * 16);
#pragma unroll
    for (int m = 0; m < 8; ++m) {
      const int R = row0 + 16 * m;
      const float* xr = xrow(p, R) + c0;
      float* orow = p.out + (size_t)R * DM + c0;
#pragma unroll
      for (int n = 0; n < 4; ++n) { f32x4 xv = *(const f32x4*)(xr + n * 16); *(f32x4*)(orow + n * 16) = xv + g[n] * acc[m][n]; }
    }
  }
};
struct EpiMlpIn {
  const Params& p;
  __device__ __forceinline__ void operator()(f32x4 (&acc)[8][4], int row0, int pn, int wc, int fq) const {
    bf16_t* hid = (bf16_t*)(p.ws + OFF_PROJ);
    const int c0 = pn * 256 + wc * 64 + fq * 4;
#pragma unroll
    for (int m = 0; m < 8; ++m) {
      bf16_t* rowp = hid + (size_t)(row0 + 16 * m) * DFF + c0;
#pragma unroll
      for (int n = 0; n < 4; ++n) {
        f32x4 v = acc[m][n];
#pragma unroll
        for (int r = 0; r < 4; ++r) { float t = fmaxf(v[r], 0.f); v[r] = t * t; }
        *(u32x2*)(rowp + n * 16) = (u32x2){pack_bf16(v[0], v[1]), pack_bf16(v[2], v[3])};
      }
    }
  }
};
struct EpiMlpOut {
  const Params& p;
  __device__ __forceinline__ void operator()(f32x4 (&acc)[8][4], int row0, int pn, int wc, int fq) const {
    const float* mod = (const float*)(p.ws + OFF_MOD);
    const int c0 = pn * 256 + wc * 64 + fq * 4;
    const float* gt = mod + row_batch(row0) * 6144 + 5120 + c0;
    f32x4 g[4];
#pragma unroll
    for (int n = 0; n < 4; ++n) g[n] = *(const f32x4*)(gt + n * 16);
#pragma unroll
    for (int m = 0; m < 8; ++m) {
      float* orow = p.out + (size_t)(row0 + 16 * m) * DM + c0;
#pragma unroll
      for (int n = 0; n < 4; ++n) { f32x4 xv = *(const f32x4*)(orow + n * 16);
#if DBG == 3
        *(f32x4*)(orow + n * 16) = xv;
#else
        *(f32x4*)(orow + n * 16) = xv + g[n] * acc[m][n];
#endif
      }
    }
  }
};

template <class Epi>
__device__ __forceinline__ void gemm_phase(lchar* shm, const bf16_t* A, int lda, int ksplit, int kjump, const bf16_t* Bt, int K, int N, const Epi& epi) {
  const int nM = NTOK / 256, nN = N / 256;
  for (int u = blockIdx.x; u < nM * nN; u += gridDim.x) { int pm, pn; unit_map(u, nM, nN, pm, pn); gemm_unit(shm, A, lda, ksplit, kjump, Bt, K, pm, pn, epi); }
}


__device__ __forceinline__ int perm32(int rho) { const int n = rho >> 4, i = rho & 15; return 8 * (i >> 2) + 4 * n + (i & 3); }
__device__ __forceinline__ int invperm32(int w) { return 16 * ((w >> 2) & 1) + 4 * (w >> 3) + (w & 3); }
template <class Epi>
__device__ __forceinline__ void gemm_phase8(lchar* lds, const bf16_t* A, int lda, int ksplit, int kjump, const bf16_t* Bt, int K, int N, const Epi& E) {
  constexpr int HTB = 128 * 64 * 2;
  const int tid = threadIdx.x, wid = __builtin_amdgcn_readfirstlane(tid >> 6), lane = tid & 63, wr = wid >> 2, wc = wid & 3, fr = lane & 15, fq = lane >> 4;
  const int nt = K / 64, nM = NTOK / 256, nN = N / 256, nU = nM * nN, G = gridDim.x;
  unsigned voffA[2], voffB[2];
#pragma unroll
  for (int i = 0; i < 2; ++i) { int R, C; stage_rc2(tid * 16 + i * 8192, R, C); voffA[i] = (unsigned)(R * lda + C) * 2u; voffB[i] = (unsigned)(R * K + C) * 2u; }
  const size_t kstep = 128, hstepA = (size_t)128 * lda * 2, hstepB = (size_t)128 * K * 2, tstepA = 2 * hstepA, tstepB = 2 * hstepB;
  const unsigned ldsw = (unsigned)wid * 1024u;
  const int aoff = lds_byte2(wr * 64 + fr, fq * 8), boff = lds_byte2(wc * 32 + fr, fq * 8);
#define ACOLB(t) ((size_t)(((t) * 64 + (((t) * 64 >= ksplit) ? kjump : 0)) * 2))
#define P8_SA(b, h) (((b) * 2 + (h)) * HTB)
#define P8_SB(b, h) ((4 + (b) * 2 + (h)) * HTB)
#define P8_STAGE(bufoff, gbase, voff) do { _Pragma("unroll") for (int _i = 0; _i < 2; ++_i) \
    __builtin_amdgcn_global_load_lds((const unsigned*)((const char*)(gbase) + (voff)[_i]), (LAS unsigned*)(lds + (bufoff) + ldsw + _i * 8192), 16, 0, 0); } while (0)
#define P8_LDA(dst, b, h) do { _Pragma("unroll") for (int m = 0; m < 4; ++m) _Pragma("unroll") for (int k = 0; k < 2; ++k) dst[m][k] = *(const LAS bf16x8*)(lds + P8_SA(b, h) + aoff + m * 2048 + k * 1024); } while (0)
#define P8_LDB(dst, b, h) do { _Pragma("unroll") for (int n = 0; n < 2; ++n) _Pragma("unroll") for (int k = 0; k < 2; ++k) dst[n][k] = *(const LAS bf16x8*)(lds + P8_SB(b, h) + boff + n * 2048 + k * 1024); } while (0)
#define P8_MMA(ai, bj, At_, Bt_) do { __builtin_amdgcn_s_setprio(1); _Pragma("unroll") for (int m = 0; m < 4; ++m) _Pragma("unroll") for (int n = 0; n < 2; ++n) _Pragma("unroll") for (int k = 0; k < 2; ++k) \
    acc[ai][bj][m][n] = __builtin_amdgcn_mfma_f32_16x16x32_bf16(Bt_[n][k], At_[m][k], acc[ai][bj][m][n], 0, 0, 0); __builtin_amdgcn_s_setprio(0); } while (0)
#define P8_WAIT_V(n) asm volatile("s_waitcnt vmcnt(" #n ")" ::: "memory")
#define P8_WAIT_L(n) asm volatile("s_waitcnt lgkmcnt(" #n ")" ::: "memory")
#define P8_BAR __builtin_amdgcn_s_barrier()
#define P8_SCHED __builtin_amdgcn_sched_barrier(0)
  int ui = 0, cpm, cpn, npm = 0, npn = 0;
  if ((int)blockIdx.x >= nU) return;
  unit_map(blockIdx.x, nM, nN, cpm, cpn);
  f32x4 acc[2][2][4][2];
#pragma unroll
  for (int a = 0; a < 2; ++a)
#pragma unroll
    for (int b = 0; b < 2; ++b)
#pragma unroll
      for (int m = 0; m < 4; ++m)
#pragma unroll
        for (int n = 0; n < 2; ++n) acc[a][b][m][n] = (f32x4){0.f, 0.f, 0.f, 0.f};
  bf16x8 At[4][2], B0[2][2], B1[2][2];
  const char* cA = (const char*)A + (size_t)cpm * tstepA; const char* cB = (const char*)Bt + (size_t)cpn * tstepB;
  P8_STAGE(P8_SB(0, 0), cB, voffB); P8_STAGE(P8_SA(0, 0), cA + ACOLB(0), voffA); P8_STAGE(P8_SB(0, 1), cB + hstepB, voffB); P8_STAGE(P8_SA(0, 1), cA + ACOLB(0) + hstepA, voffA);
  if (wr == 1) P8_BAR;
  P8_WAIT_V(4); P8_BAR;
  P8_STAGE(P8_SB(1, 0), cB + kstep, voffB); P8_STAGE(P8_SA(1, 0), cA + ACOLB(1), voffA); P8_STAGE(P8_SB(1, 1), cB + hstepB + kstep, voffB);
  P8_WAIT_V(6); P8_BAR;
  for (;;) {
    const int nu = (ui + 1) * G + (int)blockIdx.x;
    const bool has_next = nu < nU;
    if (has_next) unit_map(nu, nM, nN, npm, npn);
    const char* nA = has_next ? (const char*)A + (size_t)npm * tstepA : cA; const char* nB = has_next ? (const char*)Bt + (size_t)npn * tstepB : cB;
    for (int t = 0; t < nt; t += 2) {
      const bool last = (t == nt - 2);
      const char* a1 = cA + ACOLB(t + 1);
      const char* a2 = last ? nA + ACOLB(0) : cA + ACOLB(t + 2); const char* b2 = last ? nB : cB + (size_t)(t + 2) * kstep;
      const char* a3 = a2 + kstep; const char* b3 = b2 + kstep;
      P8_LDB(B0, 0, 0); P8_SCHED; P8_LDA(At, 0, 0); P8_STAGE(P8_SA(1, 1), a1 + hstepA, voffA);
      P8_WAIT_L(8); P8_BAR; P8_WAIT_L(0); P8_MMA(0, 0, At, B0); P8_BAR; P8_SCHED;
      P8_LDB(B1, 0, 1); P8_STAGE(P8_SB(0, 0), b2, voffB);
      P8_BAR; P8_WAIT_L(0); P8_MMA(0, 1, At, B1); P8_BAR;
      P8_LDA(At, 0, 1); P8_STAGE(P8_SA(0, 0), a2, voffA);
      P8_BAR; P8_WAIT_L(0); P8_MMA(1, 0, At, B0); P8_BAR; P8_SCHED;
      P8_STAGE(P8_SB(0, 1), b2 + hstepB, voffB);
      P8_WAIT_V(6); P8_BAR; P8_MMA(1, 1, At, B1); P8_BAR;
      P8_LDB(B0, 1, 0); P8_SCHED; P8_LDA(At, 1, 0); P8_STAGE(P8_SA(0, 1), a2 + hstepA, voffA);
      P8_WAIT_L(8); P8_BAR; P8_WAIT_L(0); P8_MMA(0, 0, At, B0); P8_BAR; P8_SCHED;
      P8_LDB(B1, 1, 1); P8_STAGE(P8_SB(1, 0), b3, voffB);
      P8_BAR; P8_WAIT_L(0); P8_MMA(0, 1, At, B1); P8_BAR;
      P8_LDA(At, 1, 1); P8_STAGE(P8_SA(1, 0), a3, voffA);
      P8_BAR; P8_WAIT_L(0); P8_MMA(1, 0, At, B0); P8_BAR; P8_SCHED;
      P8_STAGE(P8_SB(1, 1), b3 + hstepB, voffB);
      P8_WAIT_V(6); P8_BAR; P8_MMA(1, 1, At, B1); P8_BAR;
    }
    E(acc, cpm, cpn, wr, wc, fr, fq);
    if (!has_next) break;
#pragma unroll
    for (int a = 0; a < 2; ++a)
#pragma unroll
      for (int b = 0; b < 2; ++b)
#pragma unroll
        for (int m = 0; m < 4; ++m)
#pragma unroll
          for (int n = 0; n < 2; ++n) acc[a][b][m][n] = (f32x4){0.f, 0.f, 0.f, 0.f};
    cpm = npm; cpn = npn; cA = nA; cB = nB; ++ui;
  }
  P8_WAIT_V(0);
  if (wr == 0) P8_BAR;
  P8_BAR;
#undef ACOLB
#undef P8_SA
#undef P8_SB
#undef P8_STAGE
#undef P8_LDA
#undef P8_LDB
#undef P8_MMA
#undef P8_WAIT_V
#undef P8_WAIT_L
#undef P8_BAR
#undef P8_SCHED
}

struct Epi8InProj {
  const Params& p;
  __device__ __forceinline__ void operator()(f32x4 (&acc)[2][2][4][2], int pm, int pn, int wr, int wc, int fr, int fq) const {
    bf16_t* proj = (bf16_t*)(p.ws + OFF_PROJ);
    const f32x4* rotA = (const f32x4*)(p.ws + OFF_ROT);
    const f32x4* rotB = rotA + 128 * 32;
    const int kind = pn >> 1;
    const int head = wc >> 1, j0 = (wc & 1) * 32 + 8 * fq;
#pragma unroll
    for (int ai = 0; ai < 2; ++ai) {
      const int R0 = pm * 256 + ai * 128 + wr * 64 + fr;
      if (kind == 1 || kind == 2) {
        const float sc = (kind == 2) ? 0.08838834764831845f : 1.f;
        const int pos0 = row_pos(R0);
        f32x4 ra[4], rbb[2][4];
#pragma unroll
        for (int q = 0; q < 4; ++q) ra[q] = rotA[((pos0 >> 7) * 64 + j0) / 2 + q];
#pragma unroll
        for (int q = 0; q < 4; ++q) rbb[0][q] = rotB[((pos0 & 127) * 64 + j0) / 2 + q];
#pragma unroll
        for (int m = 0; m < 4; ++m) {
          const int R = R0 + 16 * m;
          if (m < 3) {
#pragma unroll
            for (int q = 0; q < 4; ++q) rbb[(m + 1) & 1][q] = rotB[(((pos0 + 16 * (m + 1)) & 127) * 64 + j0) / 2 + q];
          }
          const f32x4 (&rb)[4] = rbb[m & 1];
          float o1[8], o2[8];
#pragma unroll
          for (int e = 0; e < 8; ++e) {
            const float ca = ra[e >> 1][(e & 1) * 2], sa = ra[e >> 1][(e & 1) * 2 + 1], cb = rb[e >> 1][(e & 1) * 2], sb = rb[e >> 1][(e & 1) * 2 + 1];
            const float c = ca * cb - sa * sb, s = sa * cb + ca * sb;
            const float x1 = acc[ai][0][m][e >> 2][e & 3], x2 = acc[ai][1][m][e >> 2][e & 3];
            o1[e] = (x1 * c - x2 * s) * sc; o2[e] = (x1 * s + x2 * c) * sc;
          }
          bf16_t* rowp = proj + (size_t)R * INW + pn * 256 + head * 128 + j0;
          *(u32x4*)(rowp) = (u32x4){pack_bf16(o1[0], o1[1]), pack_bf16(o1[2], o1[3]), pack_bf16(o1[4], o1[5]), pack_bf16(o1[6], o1[7])};
          *(u32x4*)(rowp + 64) = (u32x4){pack_bf16(o2[0], o2[1]), pack_bf16(o2[2], o2[3]), pack_bf16(o2[4], o2[5]), pack_bf16(o2[6], o2[7])};
        }
      } else {
#pragma unroll
        for (int m = 0; m < 4; ++m) {
          bf16_t* rowp = proj + (size_t)(R0 + 16 * m) * INW + pn * 256 + head * 128 + j0;
#pragma unroll
          for (int bj = 0; bj < 2; ++bj) {
            f32x4 v0 = acc[ai][bj][m][0], v1 = acc[ai][bj][m][1];
            if (kind == 4) {
#pragma unroll
              for (int r = 0; r < 4; ++r) { v0[r] = silu_f(v0[r]); v1[r] = silu_f(v1[r]); }
            }
            *(u32x4*)(rowp + bj * 64) = (u32x4){pack_bf16(v0[0], v0[1]), pack_bf16(v0[2], v0[3]), pack_bf16(v1[0], v1[1]), pack_bf16(v1[2], v1[3])};
          }
        }
      }
    }
  }
};
template <int GT_OFF, bool INPLACE>
struct Epi8Resid {
  const Params& p;
  __device__ __forceinline__ void operator()(f32x4 (&acc)[2][2][4][2], int pm, int pn, int wr, int wc, int fr, int fq) const {
    const float* mod = (const float*)(p.ws + OFF_MOD);
    const int c0 = pn * 256 + wc * 32 + fq * 4;
    const float* gt = mod + row_batch(pm * 256) * 6144 + GT_OFF + c0;
    f32x4 g[2][2];
#pragma unroll
    for (int bj = 0; bj < 2; ++bj)
#pragma unroll
      for (int n = 0; n < 2; ++n) g[bj][n] = *(const f32x4*)(gt + bj * 128 + n * 16);
#pragma unroll
    for (int ai = 0; ai < 2; ++ai)
#pragma unroll
      for (int m = 0; m < 4; ++m) {
        const int R = pm * 256 + ai * 128 + wr * 64 + m * 16 + fr;
        const float* xr = (INPLACE ? (const float*)(p.out + (size_t)R * DM) : xrow(p, R)) + c0;
        float* orow = p.out + (size_t)R * DM + c0;
#pragma unroll
        for (int bj = 0; bj < 2; ++bj)
#pragma unroll
          for (int n = 0; n < 2; ++n) { const f32x4 xv = *(const f32x4*)(xr + bj * 128 + n * 16); *(f32x4*)(orow + bj * 128 + n * 16) = xv + g[bj][n] * acc[ai][bj][m][n]; }
      }
  }
};
struct Epi8OutProj {
  const Params& p;
  __device__ __forceinline__ void operator()(f32x4 (&acc)[2][2][4][2], int pm, int pn, int wr, int wc, int fr, int fq) const {
    const float* mod = (const float*)(p.ws + OFF_MOD) + row_batch(pm * 256) * 6144;
    const float* xbase = xrow(p, pm * 256);
    bf16_t* x1base = (bf16_t*)((char*)p.out + OUT_H) + (size_t)pm * 256 * DM;
    bf16_t* h2base = (bf16_t*)(p.ws + OFF_H2) + (size_t)pm * 256 * DM;
    float* ssq = (float*)(p.ws + OFF_SSQ) + pm * 256;
    const int c0 = pn * 256 + wc * 32 + fq * 8;
    const unsigned lo = (unsigned)((wr * 64 + fr) * DM + c0);
    float ssv[8];
#pragma unroll
    for (int gi = 0; gi < 8; ++gi) ssv[gi] = 0.f;
#pragma unroll
    for (int bj = 0; bj < 2; ++bj) {
      f32x4 g[2], a2[2];
#pragma unroll
      for (int n = 0; n < 2; ++n) {
        const int c = c0 + bj * 128 + n * 4;
        g[n] = *(const f32x4*)(mod + 2048 + c);
        a2[n] = *(const f32x4*)(p.norm_mlp + c) * (*(const f32x4*)(mod + 4096 + c) + 1.f);
      }
      f32x4 xv[2][2];
#pragma unroll
      for (int n = 0; n < 2; ++n) xv[0][n] = __builtin_nontemporal_load((const f32x4*)(xbase + lo + (unsigned)(bj * 128 + n * 4)));
#pragma unroll
      for (int gi = 0; gi < 8; ++gi) {
        const int ai = gi >> 2, m = gi & 3;
        if (gi < 7) {
#pragma unroll
          for (int n = 0; n < 2; ++n) xv[(gi + 1) & 1][n] = __builtin_nontemporal_load((const f32x4*)(xbase + lo + (unsigned)((((gi + 1) >> 2) * 128 + ((gi + 1) & 3) * 16) * DM + bj * 128 + n * 4)));
        }
        const unsigned ro = lo + (unsigned)((ai * 128 + m * 16) * DM + bj * 128);
        const f32x4 v0 = xv[gi & 1][0] + g[0] * acc[ai][bj][m][0], v1 = xv[gi & 1][1] + g[1] * acc[ai][bj][m][1];
        *(u32x4*)(x1base + ro) = (u32x4){pack_bf16(v0[0], v0[1]), pack_bf16(v0[2], v0[3]), pack_bf16(v1[0], v1[1]), pack_bf16(v1[2], v1[3])};
        ssv[gi] += (v0[0] * v0[0] + v0[1] * v0[1] + v0[2] * v0[2] + v0[3] * v0[3]) + (v1[0] * v1[0] + v1[1] * v1[1] + v1[2] * v1[2] + v1[3] * v1[3]);
        const f32x4 h0 = v0 * a2[0], h1 = v1 * a2[1];
        *(u32x4*)(h2base + ro) = (u32x4){pack_bf16(h0[0], h0[1]), pack_bf16(h0[2], h0[3]), pack_bf16(h1[0], h1[1]), pack_bf16(h1[2], h1[3])};
      }
    }
#pragma unroll
    for (int gi = 0; gi < 8; ++gi) {
      float ss = ssv[gi];
      ss += __shfl_xor(ss, 16); ss += __shfl_xor(ss, 32);
      if (fq == 0) atomicAdd(ssq + wr * 64 + fr + (gi >> 2) * 128 + (gi & 3) * 16, ss);
    }
  }
};
struct Epi8MlpOut {
  const Params& p;
  __device__ __forceinline__ void operator()(f32x4 (&acc)[2][2][4][2], int pm, int pn, int wr, int wc, int fr, int fq) const {
    const float* mod = (const float*)(p.ws + OFF_MOD);
    const int c0 = pn * 256 + wc * 32 + fq * 8;
    const float* gt = mod + row_batch(pm * 256) * 6144 + 5120 + c0;
    const bf16_t* x1base = (const bf16_t*)((const char*)p.out + OUT_H) + (size_t)pm * 256 * DM;
    bf16_t* x2base = (bf16_t*)(p.ws + OFF_H2) + (size_t)pm * 256 * DM;
    const unsigned lo = (unsigned)((wr * 64 + fr) * DM + c0);
    f32x4 g[2][2];
#pragma unroll
    for (int bj = 0; bj < 2; ++bj)
#pragma unroll
      for (int n = 0; n < 2; ++n) g[bj][n] = *(const f32x4*)(gt + bj * 128 + n * 4);
    u32x4 xv[2][2];
#pragma unroll
    for (int bj = 0; bj < 2; ++bj) xv[0][bj] = __builtin_nontemporal_load((const u32x4*)(x1base + lo + (unsigned)(bj * 128)));
#pragma unroll
    for (int gi = 0; gi < 8; ++gi) {
      const int ai = gi >> 2, m = gi & 3;
      if (gi < 7) {
#pragma unroll
        for (int bj = 0; bj < 2; ++bj) xv[(gi + 1) & 1][bj] = __builtin_nontemporal_load((const u32x4*)(x1base + lo + (unsigned)((((gi + 1) >> 2) * 128 + ((gi + 1) & 3) * 16) * DM + bj * 128)));
      }
      const unsigned ro = lo + (unsigned)((ai * 128 + m * 16) * DM);
#pragma unroll
      for (int bj = 0; bj < 2; ++bj) {
        const u32x4 xb = xv[gi & 1][bj];
        const f32x4 x0 = (f32x4){bf_lo(xb[0]), bf_hi(xb[0]), bf_lo(xb[1]), bf_hi(xb[1])}, x1 = (f32x4){bf_lo(xb[2]), bf_hi(xb[2]), bf_lo(xb[3]), bf_hi(xb[3])};
        const f32x4 v0 = x0 + g[bj][0] * acc[ai][bj][m][0], v1 = x1 + g[bj][1] * acc[ai][bj][m][1];
        *(u32x4*)(x2base + ro + bj * 128) = (u32x4){pack_bf16(v0[0], v0[1]), pack_bf16(v0[2], v0[3]), pack_bf16(v1[0], v1[1]), pack_bf16(v1[2], v1[3])};
      }
    }
  }
};
struct Epi8MlpIn {
  const Params& p;
  __device__ __forceinline__ void operator()(f32x4 (&acc)[2][2][4][2], int pm, int pn, int wr, int wc, int fr, int fq) const {
    bf16_t* hidbase = (bf16_t*)(p.ws + OFF_PROJ) + (size_t)pm * 256 * DFF;
    const float* ssq = (const float*)(p.ws + OFF_SSQ);
    const int c0 = pn * 256 + wc * 32 + fq * 8;
    const unsigned lo = (unsigned)((wr * 64 + fr) * DFF + c0);
    const float* b2 = (const float*)(p.ws + OFF_BIAS2) + row_batch(pm * 256) * DFF + c0;
    f32x4 bias[2][2];
#pragma unroll
    for (int bj = 0; bj < 2; ++bj)
#pragma unroll
      for (int n = 0; n < 2; ++n) bias[bj][n] = *(const f32x4*)(b2 + bj * 128 + n * 4);
    float rsv[8];
#pragma unroll
    for (int gi = 0; gi < 8; ++gi) rsv[gi] = ssq[pm * 256 + (gi >> 2) * 128 + wr * 64 + (gi & 3) * 16 + fr];
#pragma unroll
    for (int ai = 0; ai < 2; ++ai)
#pragma unroll
      for (int m = 0; m < 4; ++m) {
        const float rs = rsqrtf(rsv[ai * 4 + m] * (1.f / 1024.f) + 1e-6f);
        bf16_t* rowp = hidbase + (lo + (unsigned)((ai * 128 + m * 16) * DFF));
#pragma unroll
        for (int bj = 0; bj < 2; ++bj) {
          float v[8];
#pragma unroll
          for (int e = 0; e < 8; ++e) { const float t = fmaxf(acc[ai][bj][m][e >> 2][e & 3] * rs + bias[bj][e >> 2][e & 3], 0.f); v[e] = t * t; }
          __builtin_nontemporal_store((u32x4){pack_bf16(v[0], v[1]), pack_bf16(v[2], v[3]), pack_bf16(v[4], v[5]), pack_bf16(v[6], v[7])}, (u32x4*)(rowp + bj * 128));
        }
      }
  }
};

__device__ __forceinline__ int t_sw(int row) { return ((row & 3) << 2) | ((row >> 2) & 3); }
__device__ __forceinline__ int t_off(int row, int ch) { return 256 * row + 16 * (ch ^ t_sw(row)); }

__device__ __forceinline__ void tile_glds(lchar* dst, const bf16_t* src, size_t ld) {
  const int tid = threadIdx.x, wid = tid >> 6;
#pragma unroll
  for (int i = 0; i < 4; ++i) {
    const int L = i * 512 + tid, row = L >> 4, ch = (L & 15) ^ t_sw(row);
    __builtin_amdgcn_global_load_lds((const unsigned*)(src + (size_t)row * ld + ch * 8), (LAS unsigned*)(dst + (i * 512 + wid * 64) * 16), 16, 0, 0);
  }
}
__device__ __forceinline__ bf16x8 frag_row(const lchar* tile, int rbase, int ks, int fr, int fq) {
  return *(const LAS bf16x8*)(tile + t_off(rbase + fr, 4 * ks + fq));
}
__device__ __forceinline__ bf16x8 frag_tr(const lchar* tile, int c, int ks, int lane) {
  const int g = lane >> 4, q = (lane & 15) >> 2, pp = lane & 3;
  const int r0 = 32 * ks + 8 * g + q;
  s16x4 lo = __builtin_amdgcn_ds_read_tr16_b64_v4i16((LAS s16x4*)(tile + t_off(r0, 2 * c + (pp >> 1)) + 8 * (pp & 1)));
  s16x4 hi = __builtin_amdgcn_ds_read_tr16_b64_v4i16((LAS s16x4*)(tile + t_off(r0 + 4, 2 * c + (pp >> 1)) + 8 * (pp & 1)));
  return (bf16x8){lo[0], lo[1], lo[2], lo[3], hi[0], hi[1], hi[2], hi[3]};
}
template <bool ATR, bool BTR>
__device__ __forceinline__ void mm128(f32x4 (&acc)[2][4], const lchar* At, const lchar* Bt) {
  const int tid = threadIdx.x, wid = tid >> 6, lane = tid & 63, wr = wid >> 1, wc = wid & 1, fr = lane & 15, fq = lane >> 4;
  bf16x8 a[2][2], b[2][4];
#pragma unroll
  for (int m = 0; m < 2; ++m) a[0][m] = ATR ? frag_tr(At, wr * 2 + m, 0, lane) : frag_row(At, wr * 32 + m * 16, 0, fr, fq);
#pragma unroll
  for (int n = 0; n < 4; ++n) b[0][n] = BTR ? frag_tr(Bt, wc * 4 + n, 0, lane) : frag_row(Bt, wc * 64 + n * 16, 0, fr, fq);
#pragma unroll
  for (int ks = 0; ks < 4; ++ks) {
    const int c = ks & 1, d = c ^ 1;
    if (ks < 3) {
#pragma unroll
      for (int m = 0; m < 2; ++m) a[d][m] = ATR ? frag_tr(At, wr * 2 + m, ks + 1, lane) : frag_row(At, wr * 32 + m * 16, ks + 1, fr, fq);
#pragma unroll
      for (int n = 0; n < 4; ++n) b[d][n] = BTR ? frag_tr(Bt, wc * 4 + n, ks + 1, lane) : frag_row(Bt, wc * 64 + n * 16, ks + 1, fr, fq);
    }
#pragma unroll
    for (int m = 0; m < 2; ++m)
#pragma unroll
      for (int n = 0; n < 4; ++n) acc[m][n] = __builtin_amdgcn_mfma_f32_16x16x32_bf16(b[c][n], a[c][m], acc[m][n], 0, 0, 0);
    __builtin_amdgcn_sched_barrier(0);
  }
}
__device__ __forceinline__ void zero_acc(f32x4 (&acc)[2][4]) {
#pragma unroll
  for (int m = 0; m < 2; ++m)
#pragma unroll
    for (int n = 0; n < 4; ++n) acc[m][n] = (f32x4){0.f, 0.f, 0.f, 0.f};
}
__device__ __forceinline__ void acc_to_image(lchar* tile, const f32x4 (&acc)[2][4]) {
  const int tid = threadIdx.x, wid = tid >> 6, lane = tid & 63, wr = wid >> 1, wc = wid & 1, fr = lane & 15, fq = lane >> 4;
#pragma unroll
  for (int m = 0; m < 2; ++m)
#pragma unroll
    for (int n = 0; n < 4; ++n) {
      const int row = wr * 32 + m * 16 + fr, col = wc * 64 + n * 16 + fq * 4;
      *(LAS u32x2*)(tile + t_off(row, col >> 3) + (col & 7) * 2) = (u32x2){pack_bf16(acc[m][n][0], acc[m][n][1]), pack_bf16(acc[m][n][2], acc[m][n][3])};
    }
}

__device__ void transpose_item(const Params& p, lchar* shm, int t) {
  constexpr int T_IN = 16 * 10, T_OUT = 16 * 4, T_1 = 16 * 16;
  const int tid = threadIdx.x; char* ws = p.ws;
  const float* src; bf16_t* dst; int K, N, perm = 0;
  if (t < T_IN) { src = p.w_in; dst = (bf16_t*)(ws + OFF_WIN); K = 1024; N = INW; perm = 1; }
  else if ((t -= T_IN) < T_OUT) { src = p.w_out; dst = (bf16_t*)(ws + OFF_WOUT); K = 1024; N = 1024; perm = 2; }
  else if ((t -= T_OUT) < T_1) { src = p.w_mlp_in; dst = (bf16_t*)(ws + OFF_W1); K = 1024; N = DFF; perm = 2; }
  else { t -= T_1; src = p.w_mlp_out; dst = (bf16_t*)(ws + OFF_W2); K = DFF; N = 1024; perm = 2; }
  const int nNt = N / 256, k0 = (t / nNt) * 64, n0 = (t % nNt) * 256;
  LAS float* tl = (LAS float*)shm;
  f32x4 ld[8];
#pragma unroll
  for (int i = 0; i < 8; ++i) { const int kk = i * 8 + (tid >> 6), nn = (tid & 63) * 4; ld[i] = *(const f32x4*)(src + (size_t)(k0 + kk) * N + n0 + nn); }
#pragma unroll
  for (int i = 0; i < 8; ++i) { const int kk = i * 8 + (tid >> 6), nn = (tid & 63) * 4; tl[kk * 257 + nn] = ld[i][0]; tl[kk * 257 + nn + 1] = ld[i][1]; tl[kk * 257 + nn + 2] = ld[i][2]; tl[kk * 257 + nn + 3] = ld[i][3]; }
  __syncthreads();
#pragma unroll
  for (int q = 0; q < 4; ++q) {
    const int nn = q * 64 + (tid >> 3), kc = tid & 7;
    float v[8];
#pragma unroll
    for (int e = 0; e < 8; ++e) v[e] = tl[(kc * 8 + e) * 257 + nn];
    int nrow = n0 + nn;
    if (perm) {
      const int a = nrow & 255, ag = a >> 5, w = a & 31;
      const int rho = 16 * ((w >> 2) & 1) + 4 * (w >> 3) + (w & 3);
      const int gi = (perm == 1) ? (((ag >> 1) & 1) * 4 + (ag >> 2) * 2 + (ag & 1)) : ag;
      nrow = (nrow & ~255) + gi * 32 + rho;
    }
    *(u32x4*)(dst + (size_t)nrow * K + k0 + kc * 8) = (u32x4){pack_bf16(v[0], v[1]), pack_bf16(v[2], v[3]), pack_bf16(v[4], v[5]), pack_bf16(v[6], v[7])};
  }
  __syncthreads();
}
__device__ void late_transposes(const Params& p, lchar* shm) {
  const int half = gridDim.x >> 1;
  if ((int)blockIdx.x >= half) for (int t = 160 + (int)blockIdx.x - half; t < 160 + 576; t += (int)gridDim.x - half) transpose_item(p, shm, t);
}

__device__ void phase0a(const Params& p, lchar* shm) {
  const int tid = threadIdx.x, wid = tid >> 6, lane = tid & 63;
  const int gtid = (gridDim.x - 1 - blockIdx.x) * 512 + tid, gsz = gridDim.x * 512;
  char* ws = p.ws;
  {
    float2* rot = (float2*)(ws + OFF_ROT);
    bf16_t* ft = (bf16_t*)(ws + OFF_FTAB);
    float2* twp = (float2*)(ws + OFF_TWP);
    float2* tws = (float2*)(ws + OFF_TWS);
    float* gp = (float*)(ws + OFF_GPOW);
    constexpr int T0 = 16384, T1 = T0 + 5 * 16384, T2 = T1 + 16384, T3 = T2 + 2048, T4 = T3 + 2 * 4 * 132, T5 = T4 + NTOK;
    const int nthr = gsz > 160 * 512 ? 160 * 512 : gsz;
    if (gtid < nthr) for (int w = gtid; w < T5; w += nthr) {
      if (w < T0) {
        const int idx = w, which = idx >> 13, e = idx & 8191, a = e >> 6, j = e & 63;
        double inv = 1.0; for (int t = 0; t < j; ++t) inv *= 0.8659643233600653;
        const double ang = (which ? (double)a : 128.0 * (double)a) * inv;
        double s_, c_; sincos_d(ang, s_, c_);
        rot[idx] = make_float2((float)c_, (float)s_);
      } else if (w < T1) {
        const int idx = w - T0, t = idx >> 14, e = idx & 16383, row = e >> 7, col = e & 127;
        double s_, c_; float v;
        if (t < 3) { sincos_d(6.283185307179586476925 * (double)((row * col) & 127) / 128.0, s_, c_); v = (t == 0) ? (float)c_ : (t == 1 ? (float)(-s_) : (float)s_); }
        else { sincos_d(6.283185307179586476925 * (double)(((row & 15) * (col & 15)) & 15) / 16.0, s_, c_); v = ((row >> 4) == (col >> 4)) ? (t == 3 ? (float)c_ : (float)s_) : 0.f; }
        ft[idx] = (bf16_t)(pack_bf16(v, 0.f) & 0xffff);
      } else if (w < T2) {
        const int idx = w - T1; double s_, c_; sincos_d(6.283185307179586476925 * (double)idx / 16384.0, s_, c_);
        const double nrm = 1.0 / sqrt(16384.0 * 128.0);
        twp[idx] = make_float2((float)(c_ * nrm), (float)(-s_ * nrm));
      } else if (w < T3) {
        const int idx = w - T2; double s_, c_; sincos_d(6.283185307179586476925 * (double)idx / 2048.0, s_, c_);
        tws[idx] = make_float2((float)(c_ / 512.0), (float)(-s_ / 512.0));
      } else if (w < T4) {
        const int idx = w - T3, dir = idx / (4 * 132), h = (idx / 132) & 3, t = idx % 132;
        double e2 = 1.0 / 32.0; for (int i = 0; i < h; ++i) e2 *= 0.5;
        if (dir) e2 *= 0.70710678118654752440;
        const double g = 1.0 - e2; double v = 1.0; for (int i = 0; i < t; ++i) v *= g;
        gp[idx] = (float)v;
      } else {
        ((float*)(ws + OFF_SSQ))[w - T4] = 0.f;
      }
    }
  }
  {
    LAS f32x2* ctab = (LAS f32x2*)shm;
    if (tid < 128) { double s, c; sincos_d(6.283185307179586476925 * (double)tid / 128.0, s, c); ctab[tid] = (f32x2){(float)c, (float)s}; }
    __syncthreads();
    bf16_t* mt = (bf16_t*)(ws + OFF_MTAB);
    for (int idx = gtid; idx < 65536; idx += gsz) {
      const int g = idx >> 14, c = (idx >> 7) & 127, d = idx & 127;
      const float* W = p.w_fnet + (size_t)g * 16384 + d;
      float mr = 0.f, mi = 0.f;
#pragma unroll 32
      for (int cc = 0; cc < 128; ++cc) { const float w = W[cc * 128]; const f32x2 t = ctab[(c * cc) & 127]; mr += t.x * w; mi -= t.y * w; }
      const int drow = (d & ~31) + invperm32(invperm32(d & 31));
      mt[(size_t)(g * 2 + 0) * 16384 + drow * 128 + c] = (bf16_t)(pack_bf16(mr, 0.f) & 0xffff);
      mt[(size_t)(g * 2 + 1) * 16384 + drow * 128 + c] = (bf16_t)(pack_bf16(mi, 0.f) & 0xffff);
    }
    __syncthreads();
  }
  constexpr int N_GEMV = 96, T_IN = 16 * 10;
  for (int item = blockIdx.x; item < N_GEMV + T_IN; item += gridDim.x) {
    if (item < N_GEMV) {
      LAS float* sc = (LAS float*)shm;
      LAS float* red = (LAS float*)(shm + 49152);
      for (int i = tid; i < NB * 1024; i += 512) { const int b = i >> 10, k = i & 1023; const float v = b < 2 ? p.c_prompt[b * 1024 + k] : p.c_sample[(b - 2) * 1024 + k]; sc[k * 12 + b] = silu_f(v); }
      __syncthreads();
      const int col = item * 64 + lane;
      float a[NB];
#pragma unroll
      for (int b = 0; b < NB; ++b) a[b] = 0.f;
      for (int k0 = wid * 128; k0 < wid * 128 + 128; k0 += 32) {
        float w[32];
#pragma unroll
        for (int u = 0; u < 32; ++u) w[u] = p.ada_w[(size_t)(k0 + u) * 6144 + col];
#pragma unroll
        for (int u = 0; u < 32; ++u) {
          const f32x4 s0 = *(const LAS f32x4*)(sc + (k0 + u) * 12), s1 = *(const LAS f32x4*)(sc + (k0 + u) * 12 + 4), s2 = *(const LAS f32x4*)(sc + (k0 + u) * 12 + 8);
          a[0] += s0[0] * w[u]; a[1] += s0[1] * w[u]; a[2] += s0[2] * w[u]; a[3] += s0[3] * w[u];
          a[4] += s1[0] * w[u]; a[5] += s1[1] * w[u]; a[6] += s1[2] * w[u]; a[7] += s1[3] * w[u];
          a[8] += s2[0] * w[u]; a[9] += s2[1] * w[u];
        }
      }
#pragma unroll
      for (int b = 0; b < NB; ++b) red[(wid * NB + b) * 64 + lane] = a[b];
      __syncthreads();
      for (int i = tid; i < NB * 64; i += 512) {
        const int b = i >> 6, l = i & 63; float s = p.ada_b[item * 64 + l];
        for (int w = 0; w < 8; ++w) s += red[(w * NB + b) * 64 + l];
        ((float*)(ws + OFF_MOD))[b * 6144 + item * 64 + l] = s;
      }
      __syncthreads();
    } else {
      transpose_item(p, shm, item - N_GEMV);
    }
  }
}

__device__ void bias2_items(const Params& p, lchar* shm) {
  const int tid = threadIdx.x, wid = tid >> 6, lane = tid & 63;
  const float* mod = (const float*)(p.ws + OFF_MOD);
  const int first = (int)gridDim.x > 64 ? (int)gridDim.x - 64 : 0;
  for (int item = (int)blockIdx.x - first; item >= 0 && item < 64; item += (int)gridDim.x - first) {
    LAS float* sc = (LAS float*)shm;
    LAS float* red = (LAS float*)(shm + 40960);
    for (int i = tid; i < NB * 1024; i += 512) sc[i] = mod[(i >> 10) * 6144 + 3072 + (i & 1023)];
    __syncthreads();
    const int col = item * 64 + lane;
    float a[NB];
#pragma unroll
    for (int b = 0; b < NB; ++b) a[b] = 0.f;
    for (int k = wid * 128; k < wid * 128 + 128; ++k) {
      const float w = p.w_mlp_in[(size_t)k * DFF + col];
#pragma unroll
      for (int b = 0; b < NB; ++b) a[b] += sc[b * 1024 + k] * w;
    }
#pragma unroll
    for (int b = 0; b < NB; ++b) red[(wid * NB + b) * 64 + lane] = a[b];
    __syncthreads();
    for (int i = tid; i < NB * 64; i += 512) {
      const int b = i >> 6, l = i & 63; float sum = 0.f;
      for (int w = 0; w < 8; ++w) sum += red[(w * NB + b) * 64 + l];
      ((float*)(p.ws + OFF_BIAS2))[b * DFF + item * 64 + l] = sum;
    }
    __syncthreads();
  }
}

__device__ __forceinline__ void row_finish(const Params& p, int which, int R, const f32x4 (&v)[4], int lane) {
  const float* mod = (const float*)(p.ws + OFF_MOD);
  float ss = 0.f;
#pragma unroll
  for (int i = 0; i < 4; ++i) ss += v[i][0] * v[i][0] + v[i][1] * v[i][1] + v[i][2] * v[i][2] + v[i][3] * v[i][3];
#pragma unroll
  for (int o = 32; o > 0; o >>= 1) ss += __shfl_xor(ss, o);
  const float rs = rsqrtf(ss * (1.f / 1024.f) + 1e-6f);
  if (which == 2) {
#pragma unroll
    for (int i = 0; i < 4; ++i) { const f32x4 g = *(const f32x4*)(p.norm_final + i * 256 + lane * 4); __builtin_nontemporal_store(v[i] * rs * g, (f32x4*)(p.out + (size_t)R * DM + i * 256 + lane * 4)); }
  } else {
    const float* md = mod + row_batch(R) * 6144 + (which ? 3072 : 0);
    const float* gain = which ? p.norm_mlp : p.norm_mix;
    bf16_t* dst = which ? (bf16_t*)(p.ws + OFF_H2) : (bf16_t*)((char*)p.out + OUT_H);
#pragma unroll
    for (int i = 0; i < 4; ++i) {
      const int col = i * 256 + lane * 4;
      const f32x4 g = *(const f32x4*)(gain + col), sh = *(const f32x4*)(md + col), sc = *(const f32x4*)(md + 1024 + col);
      const f32x4 y = v[i] * rs * g * (sc + 1.f) + sh;
      *(u32x2*)(dst + (size_t)R * DM + col) = (u32x2){pack_bf16(y[0], y[1]), pack_bf16(y[2], y[3])};
    }
  }
}
__device__ void rows_phase(const Params& p, int which) {
  const int tid = threadIdx.x, lane = tid & 63;
  const int stride = gridDim.x * 8;
  for (int R0 = blockIdx.x * 8 + (tid >> 6); R0 < NTOK; R0 += 2 * stride) {
    const int Ra = (which == 2) ? NTOK - 1 - R0 : R0;
    const int R1 = R0 + stride; const bool two = R1 < NTOK;
    const int Rb = (which == 2) ? NTOK - 1 - R1 : R1;
    f32x4 va[4], vb[4];
    if (which == 2) {
      const bf16_t* x2 = (const bf16_t*)(p.ws + OFF_H2);
      u32x2 ua[4], ub[4];
#pragma unroll
      for (int i = 0; i < 4; ++i) ua[i] = __builtin_nontemporal_load((const u32x2*)(x2 + (size_t)Ra * DM + i * 256 + lane * 4));
#pragma unroll
      for (int i = 0; i < 4; ++i) ub[i] = __builtin_nontemporal_load((const u32x2*)(x2 + (size_t)(two ? Rb : Ra) * DM + i * 256 + lane * 4));
#pragma unroll
      for (int i = 0; i < 4; ++i) { va[i] = (f32x4){bf_lo(ua[i][0]), bf_hi(ua[i][0]), bf_lo(ua[i][1]), bf_hi(ua[i][1])}; vb[i] = (f32x4){bf_lo(ub[i][0]), bf_hi(ub[i][0]), bf_lo(ub[i][1]), bf_hi(ub[i][1])}; }
    } else {
      const float* sa = which ? p.out + (size_t)Ra * DM : xrow(p, Ra);
      const float* sb = two ? (which ? p.out + (size_t)Rb * DM : xrow(p, Rb)) : sa;
#pragma unroll
      for (int i = 0; i < 4; ++i) va[i] = __builtin_nontemporal_load((const f32x4*)(sa + i * 256 + lane * 4));
#pragma unroll
      for (int i = 0; i < 4; ++i) vb[i] = __builtin_nontemporal_load((const f32x4*)(sb + i * 256 + lane * 4));
    }
    row_finish(p, which, Ra, va, lane);
    if (two) row_finish(p, which, Rb, vb, lane);
  }
}

__device__ __forceinline__ void tile_load_regs(u32x4 (&v)[4], const bf16_t* src, size_t ld) {
  const int tid = threadIdx.x;
#pragma unroll
  for (int i = 0; i < 4; ++i) { const int L = i * 512 + tid, row = L >> 4, ch = L & 15; v[i] = *(const u32x4*)(src + (size_t)row * ld + ch * 8); }
}
__device__ __forceinline__ void tile_load_regs_nt(u32x4 (&v)[4], const bf16_t* src, size_t ld) {
  const int tid = threadIdx.x;
#pragma unroll
  for (int i = 0; i < 4; ++i) { const int L = i * 512 + tid, row = L >> 4, ch = L & 15; v[i] = __builtin_nontemporal_load((const u32x4*)(src + (size_t)row * ld + ch * 8)); }
}
__device__ __forceinline__ void tile_store_regs(lchar* dst, const u32x4 (&v)[4]) {
  const int tid = threadIdx.x;
#pragma unroll
  for (int i = 0; i < 4; ++i) { const int L = i * 512 + tid, row = L >> 4, ch = L & 15; *(LAS u32x4*)(dst + t_off(row, ch)) = v[i]; }
}
__device__ __forceinline__ void load_afrags(bf16x8 (&a)[2][4], const bf16_t* tab) {
  const int tid = threadIdx.x, wid = tid >> 6, lane = tid & 63, wr = wid >> 1, fr = lane & 15, fq = lane >> 4;
#pragma unroll
  for (int m = 0; m < 2; ++m)
#pragma unroll
    for (int ks = 0; ks < 4; ++ks) a[m][ks] = *(const bf16x8*)(tab + (wr * 32 + m * 16 + fr) * 128 + ks * 32 + fq * 8);
}
template <bool BTR>
__device__ __forceinline__ void mm128_areg(f32x4 (&acc)[2][4], const bf16x8 (&a)[2][4], const lchar* Bt) {
  const int tid = threadIdx.x, wid = tid >> 6, lane = tid & 63, wc = wid & 1, fr = lane & 15, fq = lane >> 4;
  bf16x8 b[2][4];
#pragma unroll
  for (int n = 0; n < 4; ++n) b[0][n] = BTR ? frag_tr(Bt, wc * 4 + n, 0, lane) : frag_row(Bt, wc * 64 + n * 16, 0, fr, fq);
#pragma unroll
  for (int ks = 0; ks < 4; ++ks) {
    const int c = ks & 1, d = c ^ 1;
    if (ks < 3) {
#pragma unroll
      for (int n = 0; n < 4; ++n) b[d][n] = BTR ? frag_tr(Bt, wc * 4 + n, ks + 1, lane) : frag_row(Bt, wc * 64 + n * 16, ks + 1, fr, fq);
    }
#pragma unroll
    for (int m = 0; m < 2; ++m)
#pragma unroll
      for (int n = 0; n < 4; ++n) acc[m][n] = __builtin_amdgcn_mfma_f32_16x16x32_bf16(b[c][n], a[m][ks], acc[m][n], 0, 0, 0);
    __builtin_amdgcn_sched_barrier(0);
  }
}

struct FftAItem { const bf16_t* src; size_t ld; const float2* tw; size_t tbase; int s2, ns2; };
__device__ __forceinline__ FftAItem ffta_item(const Params& p, int g, int j) {
  FftAItem it; const bf16_t* proj = (const bf16_t*)(p.ws + OFF_PROJ);
  if (j < 256) { const int b = j >> 7; it.s2 = j & 127; it.ns2 = 128; it.src = proj + (size_t)(b * 16384 + it.s2) * INW + g * 128; it.ld = (size_t)128 * INW;
    it.tw = (const float2*)(p.ws + OFF_TWP); it.tbase = (size_t)(b * 4 + g) * 128 * 128 * 128; }
  else { const int jj = j - 256, b = jj >> 4; it.s2 = jj & 15; it.ns2 = 16; it.src = proj + (size_t)(PROWS + b * 2048 + it.s2) * INW + g * 128; it.ld = (size_t)16 * INW;
    it.tw = (const float2*)(p.ws + OFF_TWS); it.tbase = (size_t)16777216 + (size_t)(b * 4 + g) * 128 * 16 * 128; }
  return it;
}
__device__ void phase2(const Params& p, lchar* shm) {
  const int tid = threadIdx.x, wid = tid >> 6, lane = tid & 63, wr = wid >> 1, wc = wid & 1, fr = lane & 15, fq = lane >> 4;
  lchar *R0 = shm, *R1 = shm + 32768, *R2 = shm + 65536, *R3 = shm + 98304;
  const bf16_t* proj = (const bf16_t*)(p.ws + OFF_PROJ);
  const bf16_t* ft = (const bf16_t*)(p.ws + OFF_FTAB);
  const bf16_t* mt = (const bf16_t*)(p.ws + OFF_MTAB);
  bf16_t* tre = (bf16_t*)((char*)p.out + OUT_H);
  bf16_t* tim = tre + (size_t)NTOK * 512;
  const float* gp = (const float*)(p.ws + OFF_GPOW);
  {
    const int g = blockIdx.x & 3, nper = gridDim.x >> 2, slot = blockIdx.x >> 2;
    if (slot < nper) {
      tile_glds(R2, mt + (size_t)(g * 2) * 16384, 128);
      tile_glds(R3, mt + (size_t)(g * 2 + 1) * 16384, 128);
      bf16x8 far[2][4], fai[2][4];
      load_afrags(far, ft); load_afrags(fai, ft + 16384);
      u32x4 xr[4];
      int j = slot;
      if (j < 384) { const FftAItem it = ffta_item(p, g, j); tile_load_regs_nt(xr, it.src, it.ld); }
      WAIT_V0(); __syncthreads();
      for (; j < 384; j += nper) {
        const FftAItem it = ffta_item(p, g, j);
        tile_store_regs(R0, xr);
        __syncthreads();
        if (j + nper < 384) { const FftAItem nx = ffta_item(p, g, j + nper); tile_load_regs_nt(xr, nx.src, nx.ld); }
        float2 twv[2];
#pragma unroll
        for (int m = 0; m < 2; ++m) twv[m] = it.tw[it.s2 * (wr * 32 + m * 16 + fr)];
        f32x4 ar[2][4], ai[2][4];
        zero_acc(ar); zero_acc(ai);
        mm128_areg<true>(ar, far, R0);
        mm128_areg<true>(ai, fai, R0);
#pragma unroll
        for (int m = 0; m < 2; ++m) {
          const float2 w = twv[m];
#pragma unroll
          for (int n = 0; n < 4; ++n)
#pragma unroll
            for (int r = 0; r < 4; ++r) { const float a = ar[m][n][r], bb = ai[m][n][r]; ar[m][n][r] = a * w.x - bb * w.y; ai[m][n][r] = a * w.y + bb * w.x; }
        }
        __syncthreads();
        acc_to_image(R0, ar); acc_to_image(R1, ai);
        __syncthreads();
        zero_acc(ar); zero_acc(ai);
        mm128<false, false>(ar, R0, R2);
        mm128<false, false>(ai, R1, R3);
#pragma unroll
        for (int m = 0; m < 2; ++m) {
          const int k1 = wr * 32 + m * 16 + fr;
          const size_t rb = it.tbase + ((size_t)k1 * it.ns2 + it.s2) * 128 + wc * 64 + fq * 8;
#pragma unroll
          for (int n2 = 0; n2 < 2; ++n2) {
            const f32x4 r0 = ar[m][2 * n2] - ai[m][2 * n2], r1 = ar[m][2 * n2 + 1] - ai[m][2 * n2 + 1];
            *(u32x4*)(tre + rb + n2 * 32) = (u32x4){pack_bf16(r0[0], r0[1]), pack_bf16(r0[2], r0[3]), pack_bf16(r1[0], r1[1]), pack_bf16(r1[2], r1[3])};
          }
        }
        zero_acc(ar);
        mm128<false, false>(ar, R0, R3);
        mm128<false, false>(ar, R1, R2);
#pragma unroll
        for (int m = 0; m < 2; ++m) {
          const int k1 = wr * 32 + m * 16 + fr;
          const size_t rb = it.tbase + ((size_t)k1 * it.ns2 + it.s2) * 128 + wc * 64 + fq * 8;
#pragma unroll
          for (int n2 = 0; n2 < 2; ++n2)
            *(u32x4*)(tim + rb + n2 * 32) = (u32x4){pack_bf16(ar[m][2 * n2][0], ar[m][2 * n2][1]), pack_bf16(ar[m][2 * n2][2], ar[m][2 * n2][3]), pack_bf16(ar[m][2 * n2 + 1][0], ar[m][2 * n2 + 1][1]), pack_bf16(ar[m][2 * n2 + 1][2], ar[m][2 * n2 + 1][3])};
        }
        __syncthreads();
      }
    }
  }
  {
    u32x4 kr[4], vr[4];
    float zfv[4], zbv[4];
    int it = blockIdx.x;
    if (it < 1536) { const bf16_t* kp = proj + (size_t)(it >> 2) * 128 * INW + 1024 + (it & 3) * 128; tile_load_regs_nt(kr, kp, INW); tile_load_regs_nt(vr, kp + 512, INW);
#pragma unroll
      for (int i = 0; i < 4; ++i) { const int row = (i * 512 + tid) >> 4; zfv[i] = gp[(it & 3) * 132 + 127 - row]; zbv[i] = gp[(4 + (it & 3)) * 132 + row]; } }
    for (; it < 1536; it += gridDim.x) {
      const int cidx = it >> 2, h = it & 3;
      tile_store_regs(R0, kr);
#pragma unroll
      for (int i = 0; i < 4; ++i) {
        const int L = i * 512 + tid, row = L >> 4, ch = L & 15;
        const float zf = zfv[i], zb = zbv[i];
        u32x4 of, ob;
#pragma unroll
        for (int e = 0; e < 4; ++e) { const float lo = bf_lo(vr[i][e]), hi = bf_hi(vr[i][e]); of[e] = pack_bf16(lo * zf, hi * zf); ob[e] = pack_bf16(lo * zb, hi * zb); }
        *(LAS u32x4*)(R1 + t_off(row, ch)) = of;
        *(LAS u32x4*)(R2 + t_off(row, ch)) = ob;
      }
      __syncthreads();
      if (it + (int)gridDim.x < 1536) { const int nx = it + gridDim.x; const bf16_t* kp = proj + (size_t)(nx >> 2) * 128 * INW + 1024 + (nx & 3) * 128; tile_load_regs_nt(kr, kp, INW); tile_load_regs_nt(vr, kp + 512, INW);
#pragma unroll
        for (int i = 0; i < 4; ++i) { const int row = (i * 512 + tid) >> 4; zfv[i] = gp[(nx & 3) * 132 + 127 - row]; zbv[i] = gp[(4 + (nx & 3)) * 132 + row]; } }
      f32x4 kf[2][4], kb[2][4];
      zero_acc(kf); zero_acc(kb);
      mm128<true, true>(kf, R0, R1);
      mm128<true, true>(kb, R0, R2);
      bf16_t* kvf = (bf16_t*)((char*)p.out + OUT_KV) + (size_t)(cidx * 4 + h) * 16384;
      bf16_t* kvb = kvf + (size_t)1536 * 16384;
#pragma unroll
      for (int m = 0; m < 2; ++m) {
        const int d = wr * 32 + m * 16 + fr;
#pragma unroll
        for (int n = 0; n < 4; ++n) {
          const int e = wc * 64 + n * 16 + fq * 4;
          *(u32x2*)(kvf + d * 128 + e) = (u32x2){pack_bf16(kf[m][n][0], kf[m][n][1]), pack_bf16(kf[m][n][2], kf[m][n][3])};
          *(u32x2*)(kvb + d * 128 + e) = (u32x2){pack_bf16(kb[m][n][0], kb[m][n][1]), pack_bf16(kb[m][n][2], kb[m][n][3])};
        }
      }
      __syncthreads();
    }
  }
}

__device__ void phase3(const Params& p, lchar* shm) {
  const int tid = threadIdx.x, wid = tid >> 6, lane = tid & 63, wr = wid >> 1, wc = wid & 1, fr = lane & 15, fq = lane >> 4;
  lchar *R0 = shm, *R1 = shm + 32768, *R2 = shm + 65536, *R3 = shm + 98304;
  bf16_t* proj = (bf16_t*)(p.ws + OFF_PROJ);
  const bf16_t* ft = (const bf16_t*)(p.ws + OFF_FTAB);
  const bf16_t* tre = (const bf16_t*)((char*)p.out + OUT_H);
  const bf16_t* tim = tre + (size_t)NTOK * 512;
  const float* gp = (const float*)(p.ws + OFF_GPOW);
  {
    const unsigned* kv = (const unsigned*)((char*)p.out + OUT_KV);
    unsigned* pv = (unsigned*)(p.ws + OFF_PREV);
    const int gtid = blockIdx.x * 512 + tid, gsz = gridDim.x * 512;
#if DBG == 17
    for (int rep = 0; rep < 2; ++rep)
#endif
    for (int w = gtid; w < 16 * 8192 + 64 * 8192; w += gsz) {
      int dir, h, c0, nch;
      const int pr = w & 8191;
      if (w < 16 * 8192) { const int ch = w >> 13; dir = ch >> 3; const int b = (ch >> 2) & 1; h = ch & 3; c0 = b * 128; nch = 128; }
      else { const int ch = (w >> 13) - 16; dir = ch >> 5; const int b = (ch >> 2) & 7; h = ch & 3; c0 = 256 + b * 16; nch = 16; }
      const float g = gp[(dir * 4 + h) * 132 + 128];
      const size_t boff = (size_t)dir * 1536 * 8192 + (size_t)h * 8192 + pr;
      const unsigned* base = kv + boff; unsigned* obase = pv + boff;
      float s0 = 0.f, s1 = 0.f;
      for (int n8 = 0; n8 < nch; n8 += 16) {
        unsigned t[16];
#pragma unroll
        for (int j = 0; j < 16; ++j) { const int n = dir ? (nch - 1 - (n8 + j)) : (n8 + j); t[j] = __builtin_nontemporal_load(base + (size_t)(c0 + n) * 4 * 8192); }
#pragma unroll
        for (int j = 0; j < 16; ++j) {
          const int n = dir ? (nch - 1 - (n8 + j)) : (n8 + j);
          obase[(size_t)(c0 + n) * 4 * 8192] = pack_bf16(s0, s1);
          s0 = s0 * g + bf_lo(t[j]); s1 = s1 * g + bf_hi(t[j]);
        }
      }
    }
  }
  {
    auto tb_of = [&](int item) -> size_t {
      if (item < 1024) { const int b = item >> 9, g = (item >> 7) & 3, k1 = item & 127; return ((size_t)(b * 4 + g) * 128 + k1) * 16384; }
      const int j = item - 1024, b = j >> 6, g = (j >> 4) & 3, kg = j & 15; return (size_t)16777216 + ((size_t)(b * 4 + g) * 128 + kg * 8) * 2048;
    };
    bf16x8 fa[2][4], fs[2][4];
    u32x4 tr[4], ti[4];
    int cur_tabs = -1;
    int item = blockIdx.x;
    if (item < 1536) { const size_t tb = tb_of(item); tile_load_regs_nt(tr, tre + tb, 128); tile_load_regs_nt(ti, tim + tb, 128); }
    for (; item < 1536; item += gridDim.x) {
      const int tabs = item < 1024 ? 0 : 1;
      if (tabs != cur_tabs) { load_afrags(fa, ft + (tabs ? 3 * 16384 : 0)); load_afrags(fs, ft + (tabs ? 4 * 16384 : 2 * 16384)); cur_tabs = tabs; }
      tile_store_regs(R0, tr); tile_store_regs(R1, ti);
      __syncthreads();
      if (item + (int)gridDim.x < 1536) { const size_t tb = tb_of(item + gridDim.x); tile_load_regs_nt(tr, tre + tb, 128); tile_load_regs_nt(ti, tim + tb, 128); }
      f32x4 y[2][4];
      zero_acc(y);
      mm128_areg<true>(y, fa, R0);
      mm128_areg<true>(y, fs, R1);
      int b, g, k1;
      if (item < 1024) { b = item >> 9; g = (item >> 7) & 3; k1 = item & 127; }
      else { const int j = item - 1024; b = j >> 6; g = (j >> 4) & 3; k1 = j & 15; }
#pragma unroll
      for (int m = 0; m < 2; ++m) {
        const int o = wr * 32 + m * 16 + fr;
        const int R = tabs ? (PROWS + b * 2048 + (k1 * 8 + (o >> 4)) + 128 * (o & 15)) : (b * 16384 + k1 + 128 * o);
        bf16_t* rowp = proj + (size_t)R * INW + g * 128 + wc * 64 + fq * 8;
#pragma unroll
        for (int n2 = 0; n2 < 2; ++n2)
          *(u32x4*)(rowp + n2 * 32) = (u32x4){pack_bf16(y[m][2 * n2][0], y[m][2 * n2][1]), pack_bf16(y[m][2 * n2][2], y[m][2 * n2][3]), pack_bf16(y[m][2 * n2 + 1][0], y[m][2 * n2 + 1][1]), pack_bf16(y[m][2 * n2 + 1][2], y[m][2 * n2 + 1][3])};
      }
      __syncthreads();
    }
  }
}

__device__ void phase4(const Params& p, lchar* shm, bool dummy = false) {
  const int tid = threadIdx.x, wid = tid >> 6, lane = tid & 63, wr = wid >> 1, wc = wid & 1, fr = lane & 15, fq = lane >> 4;
  lchar *R0 = shm, *R1 = shm + 32768, *R2 = shm + 65536, *R3 = shm + 98304;
  LAS float* xt = (LAS float*)(shm + 131072);
  LAS float* red = xt + 264;
  bf16_t* proj = (bf16_t*)(p.ws + OFF_PROJ);
  const float* gp = (const float*)(p.ws + OFF_GPOW);
  const bf16_t* kvall = (const bf16_t*)(p.ws + OFF_PREV);
  for (int item = blockIdx.x; item < 1536; item += gridDim.x) {
    const int cidx = item >> 2, h = item & 3;
    bf16_t* base = proj + (size_t)cidx * 128 * INW + h * 128;
    tile_glds(R0, base + 512, INW);
    tile_glds(R1, base + 1024, INW);
    tile_glds(R2, base + 1536, INW);
    tile_glds(R3, kvall + (size_t)(cidx * 4 + h) * 16384, 128);
    if (tid < 264) xt[tid] = gp[(tid < 132 ? h : 4 + h) * 132 + (tid < 132 ? tid : tid - 132)];
    WAIT_V0(); __syncthreads();
    f32x4 s[2][4], o[2][4];
    zero_acc(s); zero_acc(o);
    mm128<false, false>(s, R0, R1);
    mm128<false, true>(o, R0, R3);
    __syncthreads();
    tile_glds(R3, kvall + (size_t)(1536 + cidx * 4 + h) * 16384, 128);
#pragma unroll
    for (int m = 0; m < 2; ++m) {
      const int i = wr * 32 + m * 16 + fr;
      const float ratio = xt[i + 1] / xt[132 + 128 - i];
#pragma unroll
      for (int n = 0; n < 4; ++n)
#pragma unroll
        for (int r = 0; r < 4; ++r) {
          const int j = wc * 64 + n * 16 + fq * 4 + r, dd = i - j;
          s[m][n][r] *= (dd >= 0) ? xt[dd] : xt[132 - dd];
          o[m][n][r] *= ratio;
        }
    }
    acc_to_image(R1, s);
    u32x4 gw[4];
#pragma unroll
    for (int i = 0; i < 4; ++i) { const int L = i * 512 + tid; gw[i] = __builtin_nontemporal_load((const u32x4*)(base + (size_t)(L >> 4) * INW + 2048 + (L & 15) * 8)); }
    WAIT_V0(); __syncthreads();
    mm128<false, true>(o, R0, R3);
#pragma unroll
    for (int m = 0; m < 2; ++m) {
      const float xb = xt[132 + 128 - (wr * 32 + m * 16 + fr)];
#pragma unroll
      for (int n = 0; n < 4; ++n) o[m][n] *= xb;
    }
    mm128<false, true>(o, R1, R2);
    float ss[2];
#pragma unroll
    for (int m = 0; m < 2; ++m) {
      float a = 0.f;
#pragma unroll
      for (int n = 0; n < 4; ++n) a += o[m][n][0] * o[m][n][0] + o[m][n][1] * o[m][n][1] + o[m][n][2] * o[m][n][2] + o[m][n][3] * o[m][n][3];
      a += __shfl_xor(a, 16); a += __shfl_xor(a, 32);
      ss[m] = a;
      if (fq == 0) red[wc * 128 + wr * 32 + m * 16 + fr] = a;
    }
    __syncthreads();
#pragma unroll
    for (int m = 0; m < 2; ++m) {
      const int i = wr * 32 + m * 16 + fr;
      const float tot = red[i] + red[128 + i];
      const float rinv = rsqrtf(tot * (1.f / 128.f) + 1e-6f);
#pragma unroll
      for (int n = 0; n < 4; ++n) o[m][n] *= rinv;
    }
    (void)ss;
    acc_to_image(R0, o);
    __syncthreads();
#pragma unroll
    for (int i = 0; i < 4; ++i) {
      const int L = i * 512 + tid, row = L >> 4, ch = L & 15;
      const u32x4 rv = *(const LAS u32x4*)(R0 + t_off(row, ch));
      u32x4 ov;
#pragma unroll
      for (int e = 0; e < 4; ++e) ov[e] = pack_bf16(bf_lo(rv[e]) * bf_lo(gw[i][e]), bf_hi(rv[e]) * bf_hi(gw[i][e]));
      *(u32x4*)(base + (size_t)row * INW + 2048 + ch * 8) = ov;
    }
    __syncthreads();
  }
}

#define XB_TMO      128
#define XB_XCNT(j)  (256  + 64 * (j))
#define XB_XSUB(j)  (1280 + 64 * (j))
#define XB_XGEN(j)  (2304 + 64 * (j))
#define XB_TOP      3328
#define XB_TOPGEN   3392
#define XCD_BAR_WORDS 3456
#define XB_SPIN_CAP (1u << 18)
__device__ __forceinline__ unsigned xb_ld(unsigned* p)              { return __hip_atomic_load(p, __ATOMIC_RELAXED, __HIP_MEMORY_SCOPE_AGENT); }
__device__ __forceinline__ unsigned xb_add(unsigned* p, unsigned v) { return __hip_atomic_fetch_add(p, v, __ATOMIC_RELAXED, __HIP_MEMORY_SCOPE_AGENT); }
__device__ __forceinline__ unsigned xb_xcc_id() { return (unsigned)__builtin_amdgcn_s_getreg((3 << 11) | 20) & 0xFu; }
#define XB_SPIN(cond, bar) do { unsigned _sp = 0; while (cond) { __builtin_amdgcn_s_sleep(1); \
    if ((++_sp & 255u) == 0u) { if (xb_ld(&(bar)[XB_TMO])) break; if (_sp > XB_SPIN_CAP) { atomicAdd(&(bar)[XB_TMO], 1u); break; } } } } while (0)
struct XcdBarrier { unsigned* bar; unsigned x; volatile LAS unsigned* st; };
__device__ __forceinline__ XcdBarrier xcd_barrier_post(unsigned* bar, volatile LAS unsigned* st) {
  XcdBarrier b; b.bar = bar; b.x = xb_xcc_id(); b.st = st;
  if (threadIdx.x == 0) (void)xb_add(&bar[XB_XCNT(b.x)], 1u);
  return b;
}
__device__ __forceinline__ void xcd_barrier_complete(unsigned* bar, unsigned x, unsigned& nloc, unsigned& nx) {
  const unsigned G = gridDim.x * gridDim.y * gridDim.z;
  unsigned sum, cnt, mine, sp = 0u;
  for (;;) {
    sum = 0u; cnt = 0u; mine = 0u;
#pragma unroll
    for (unsigned j = 0; j < 16; ++j) { const unsigned c = xb_ld(&bar[XB_XCNT(j)]); sum += c; cnt += (c > 0u) ? 1u : 0u; mine = (j == x) ? c : mine; }
    if (sum == G) break;
    __builtin_amdgcn_s_sleep(1);
    if ((++sp & 255u) == 0u) { if (xb_ld(&bar[XB_TMO])) break; if (sp > XB_SPIN_CAP) { atomicAdd(&bar[XB_TMO], 1u); break; } }
  }
  nloc = mine > 0u ? mine : 1u; nx = cnt > 0u ? cnt : 1u;
}
__device__ __forceinline__ void xcd_barrier(const XcdBarrier& b) {
  asm volatile("s_waitcnt vmcnt(0)" ::: "memory");
  __syncthreads();
  if (threadIdx.x == 0) {
    unsigned* bar = b.bar;
    __builtin_amdgcn_s_waitcnt(0);
    unsigned nloc = b.st[0], nx = b.st[1];
    if (nloc == 0u) { xcd_barrier_complete(bar, b.x, nloc, nx); b.st[0] = nloc; b.st[1] = nx; }
    const unsigned old = xb_add(&bar[XB_XSUB(b.x)], 1u);
    const unsigned gen = old / nloc;
    if (old + 1u == (gen + 1u) * nloc) {
      __builtin_amdgcn_fence(__ATOMIC_RELEASE, "agent");
      asm volatile("s_waitcnt vmcnt(0)" ::: "memory");
      const unsigned og = xb_add(&bar[XB_TOP], 1u);
      const unsigned tg = og / nx;
      if (og + 1u == (tg + 1u) * nx) xb_add(&bar[XB_TOPGEN], 1u);
      else XB_SPIN(xb_ld(&bar[XB_TOPGEN]) == tg, bar);
      __builtin_amdgcn_fence(__ATOMIC_ACQUIRE, "agent");
      xb_add(&bar[XB_XGEN(b.x)], 1u);
      asm volatile("s_waitcnt vmcnt(0)" ::: "memory");
    } else {
      XB_SPIN(xb_ld(&bar[XB_XGEN(b.x)]) == gen, bar);
      __builtin_amdgcn_fence(__ATOMIC_ACQUIRE, "agent");
      asm volatile("s_waitcnt vmcnt(0)" ::: "memory");
    }
  }
  __syncthreads();
}

template <bool COOP>
__global__ void __launch_bounds__(512) mk_forward(Params p, int ph0, int ph1) {
  __shared__ __attribute__((aligned(1024))) char shm_[LDS_BYTES];
  lchar* shm = (lchar*)shm_;
#ifdef ONLY_PHASE
#define PH_ON(k) ((k) == ONLY_PHASE)
#else
#define PH_ON(k) (ph0 <= (k) && (k) <= ph1)
#endif
  XcdBarrier xb{};
  if (COOP) {
    volatile LAS unsigned* st = (volatile LAS unsigned*)(shm + 131072 + 3584);
    if (threadIdx.x == 0) { st[0] = 0u; st[1] = 0u; st[2] = 0u; st[3] = 0u; }
    __syncthreads();
    xb = xcd_barrier_post((unsigned*)(p.ws + OFF_BAR), st);
    if (ph1 > 1000) cg::this_grid().sync();
  }
#define PH_SYNC(k) do { if (COOP && ph0 <= (k) && (k) < ph1) xcd_barrier(xb); } while (0)
  if (PH_ON(0)) phase0a(p, shm);
#if DBG == 13
  __syncthreads();
  if (PH_ON(0)) phase0a(p, shm);
#endif
  PH_SYNC(0);
  if (PH_ON(1)) rows_phase(p, 0);
#if DBG == 14
  if (PH_ON(1)) rows_phase(p, 0);
#endif
  PH_SYNC(1);
  if (PH_ON(2)) gemm_phase8(shm, (const bf16_t*)((const char*)p.out + OUT_H), DM, 1 << 30, 0, (const bf16_t*)(p.ws + OFF_WIN), DM, INW, Epi8InProj{p});
  if (PH_ON(2)) { __syncthreads(); bias2_items(p, shm); late_transposes(p, shm); }
#if DBG == 11
  __syncthreads();
  if (PH_ON(2)) gemm_phase8(shm, (const bf16_t*)((const char*)p.out + OUT_H), DM, 1 << 30, 0, (const bf16_t*)(p.ws + OFF_WIN), DM, INW, Epi8InProj{p});
#endif
  PH_SYNC(2);
  if (PH_ON(3)) phase2(p, shm);
#if DBG == 12
  __syncthreads();
  if (PH_ON(3)) phase2(p, shm);
#endif
  PH_SYNC(3);
  if (PH_ON(4)) phase3(p, shm);
  PH_SYNC(4);
#if DBG == 16
  if (PH_ON(5)) phase4(p, shm, true);
  __syncthreads();
#endif
  if (PH_ON(5)) phase4(p, shm);
  PH_SYNC(5);
  if (PH_ON(6)) gemm_phase8(shm, (const bf16_t*)(p.ws + OFF_PROJ), INW, 512, 1536, (const bf16_t*)(p.ws + OFF_WOUT), DM, DM, Epi8OutProj{p});
  PH_SYNC(6);
  if (PH_ON(8)) gemm_phase8(shm, (const bf16_t*)(p.ws + OFF_H2), DM, 1 << 30, 0, (const bf16_t*)(p.ws + OFF_W1), DM, DFF, Epi8MlpIn{p});
#if DBG == 10
  __syncthreads();
  if (PH_ON(8)) gemm_phase8(shm, (const bf16_t*)(p.ws + OFF_H2), DM, 1 << 30, 0, (const bf16_t*)(p.ws + OFF_W1), DM, DFF, Epi8MlpIn{p});
#endif
  PH_SYNC(8);
  if (PH_ON(9)) gemm_phase8(shm, (const bf16_t*)(p.ws + OFF_PROJ), DFF, 1 << 30, 0, (const bf16_t*)(p.ws + OFF_W2), DFF, DM, Epi8MlpOut{p});
  PH_SYNC(9);
  if (PH_ON(10)) rows_phase(p, 2);
}

extern "C" void kernel_launch(void* const* d_in, const int* in_sizes, int n_in, void* d_out, int out_size, void* d_ws, size_t ws_size,
                              hipStream_t stream) {
  Params p{};
  p.x_prompt = (const float*)d_in[0]; p.x_sample = (const float*)d_in[1]; p.c_prompt = (const float*)d_in[2]; p.c_sample = (const float*)d_in[3];
  p.ada_w = (const float*)d_in[4]; p.ada_b = (const float*)d_in[5]; p.norm_mix = (const float*)d_in[6]; p.w_in = (const float*)d_in[7];
  p.w_fnet = (const float*)d_in[8]; p.w_out = (const float*)d_in[9]; p.norm_mlp = (const float*)d_in[10]; p.w_mlp_in = (const float*)d_in[11];
  p.w_mlp_out = (const float*)d_in[12]; p.norm_final = (const float*)d_in[13];
  p.out = (float*)d_out; p.ws = (char*)d_ws;
  if (ws_size < WS_END) { fprintf(stderr, "workspace too small: %zu < %zu\n", ws_size, (size_t)WS_END); return; }
#if MK_COOP
  static int grid_blocks = 0;
  if (!grid_blocks) {
    int dev = 0, cus = 0, per_cu = 0;
    hipGetDevice(&dev);
    hipDeviceGetAttribute(&cus, hipDeviceAttributeMultiprocessorCount, dev);
    hipOccupancyMaxActiveBlocksPerMultiprocessor(&per_cu, mk_forward<true>, 512, 0);
    if (per_cu > 1) per_cu = 1;
    grid_blocks = cus * per_cu;
  }
  hipMemsetAsync((char*)d_ws + OFF_BAR, 0, 3456 * 4, stream);
  int ph0 = 0, ph1 = 10;
  void* args[] = {&p, &ph0, &ph1};
  hipError_t e = hipLaunchCooperativeKernel((void*)mk_forward<true>, dim3(grid_blocks), dim3(512), args, 0, stream);
  if (e != hipSuccess) fprintf(stderr, "cooperative launch failed: %s (grid %d)\n", hipGetErrorString(e), grid_blocks);
#else
  for (int ph = 0; ph <= 10; ++ph) mk_forward<false><<<256, 512, 0, stream>>>(p, ph, ph);
#endif
}
```

```cpp
#include <hip/hip_runtime.h>
#include <hip/hip_cooperative_groups.h>
#include <cstdio>
namespace cg = cooperative_groups;

#ifndef DBG
#define DBG 0
#endif
#ifndef MK_COOP
#define MK_COOP 1
#endif

#define LAS __attribute__((address_space(3)))
typedef LAS char lchar;
typedef unsigned short bf16_t;
typedef short bf16x8 __attribute__((ext_vector_type(8)));
typedef short s16x4 __attribute__((ext_vector_type(4)));
typedef float f32x4 __attribute__((ext_vector_type(4)));
typedef unsigned u32x2 __attribute__((ext_vector_type(2)));
typedef float f32x2 __attribute__((ext_vector_type(2)));
typedef unsigned u32x4 __attribute__((ext_vector_type(4)));

constexpr int NTOK = 49152, DM = 1024, INW = 2560, DFF = 4096;
constexpr int PROWS = 32768;
constexpr int NB = 10;
constexpr int LDS_BYTES = 4 * 32768 + 4096;

constexpr size_t OFF_PROJ = 0;
constexpr size_t OFF_PREV = (size_t)NTOK * INW * 2;
constexpr size_t OFF_H2   = (size_t)NTOK * DFF * 2;
constexpr size_t OFF_WIN  = OFF_H2 + (size_t)NTOK * DM * 2;
constexpr size_t OFF_WOUT = OFF_WIN + (size_t)INW * DM * 2;
constexpr size_t OFF_W1   = OFF_WOUT + (size_t)DM * DM * 2;
constexpr size_t OFF_W2   = OFF_W1 + (size_t)DFF * DM * 2;
constexpr size_t OFF_MOD  = OFF_W2 + (size_t)DFF * DM * 2;
constexpr size_t OFF_ROT  = OFF_MOD + (size_t)NB * 6144 * 4;
constexpr size_t OFF_FTAB = OFF_ROT + 2 * 128 * 64 * 8;
constexpr size_t OFF_MTAB = OFF_FTAB + 5 * 32768;
constexpr size_t OFF_TWP  = OFF_MTAB + 8 * 32768;
constexpr size_t OFF_TWS  = OFF_TWP + 16384 * 8;
constexpr size_t OFF_GPOW = OFF_TWS + 2048 * 8;
constexpr size_t OFF_BAR  = (OFF_GPOW + 2 * 4 * 132 * 4 + 255) / 256 * 256;
constexpr size_t OFF_SSQ  = OFF_BAR + 3456 * 4;
constexpr size_t OFF_BIAS2 = OFF_SSQ + (size_t)NTOK * 16 * 4;
constexpr size_t WS_END   = OFF_BIAS2 + (size_t)NB * DFF * 4;
static_assert(WS_END <= (size_t)536870912, "workspace");
constexpr size_t OUT_H   = 0;
constexpr size_t OUT_KV  = (size_t)NTOK * DM * 2;

struct Params {
  const float *x_prompt, *x_sample, *c_prompt, *c_sample, *ada_w, *ada_b, *norm_mix, *w_in, *w_fnet, *w_out,
      *norm_mlp, *w_mlp_in, *w_mlp_out, *norm_final;
  float* out;
  char* ws;
};

__device__ __forceinline__ unsigned pack_bf16(float lo, float hi) {
  unsigned r; asm("v_cvt_pk_bf16_f32 %0, %1, %2" : "=v"(r) : "v"(lo), "v"(hi)); return r;
}
__device__ __forceinline__ float bf_lo(unsigned u) { return __uint_as_float(u << 16); }
__device__ __forceinline__ float bf_hi(unsigned u) { return __uint_as_float(u & 0xffff0000u); }
__device__ __forceinline__ int row_batch(int R) { return R < PROWS ? (R >> 14) : 2 + ((R - PROWS) >> 11); }
__device__ __forceinline__ int row_pos(int R) { return R < PROWS ? (R & 16383) : ((R - PROWS) & 2047); }
__device__ __forceinline__ const float* xrow(const Params& p, int R) {
  return R < PROWS ? p.x_prompt + (size_t)R * DM : p.x_sample + (size_t)(R - PROWS) * DM;
}
__device__ __forceinline__ float silu_f(float v) { return v / (1.f + __expf(-v)); }
#define WAIT_V0() asm volatile("s_waitcnt vmcnt(0)" ::: "memory")

__device__ void sincos_d(double x, double& s, double& c) {
  double q = rint(x * 0.63661977236758134308);
  double r = fma(-q, 1.57079632679489655800e+00, x);
  r = fma(-q, 6.12323399573676603587e-17, r);
  int qi = (int)(((long long)q) & 3);
  double r2 = r * r;
  double sp = r * (1.0 + r2 * (-1.0 / 6 + r2 * (1.0 / 120 + r2 * (-1.0 / 5040 + r2 * (1.0 / 362880 + r2 * (-1.0 / 39916800 + r2 * (1.0 / 6227020800.0)))))));
  double cp = 1.0 + r2 * (-0.5 + r2 * (1.0 / 24 + r2 * (-1.0 / 720 + r2 * (1.0 / 40320 + r2 * (-1.0 / 3628800 + r2 * (1.0 / 479001600.0 + r2 * (-1.0 / 87178291200.0)))))));
  if (qi == 0) { s = sp; c = cp; } else if (qi == 1) { s = cp; c = -sp; } else if (qi == 2) { s = -sp; c = -cp; } else { s = -cp; c = sp; }
}

__device__ __forceinline__ int lds_byte2(int r, int c) {
  int st = (r >> 4) * 2 + (c >> 5), ob = (r & 15) * 64 + (c & 31) * 2;
  return st * 1024 + (ob ^ (((ob >> 9) & 1) << 5));
}
__device__ __forceinline__ void stage_rc2(int b, int& R, int& C) {
  int st = b >> 10, sb = b & 1023, swz = sb ^ (((sb >> 9) & 1) << 5);
  R = (st >> 1) * 16 + swz / 64;
  C = (st & 1) * 32 + (swz % 64) / 2;
}
__device__ __forceinline__ void unit_map(int u, int nM, int nN, int& pm, int& pn) {
  int nwg = nM * nN, wgid = u;
  { int q = nwg / 8, r = nwg % 8, xcd = wgid % 8, off = wgid / 8; wgid = (xcd < r ? xcd * (q + 1) : r * (q + 1) + (xcd - r) * q) + off; }
  int nig = 8 * nN, gid = wgid / nig, fm = gid * 8, gsz = min(nM - fm, 8);
  pm = fm + ((wgid % nig) % gsz); pn = (wgid % nig) / gsz;
}

template <class Epi>
__device__ __forceinline__ void gemm_unit(lchar* shm, const bf16_t* __restrict__ A, int lda, int ksplit, int kjump,
                                          const bf16_t* __restrict__ Bt, int K, int pm, int pn, const Epi& epi) {
  constexpr int TILE_B = 256 * 64 * 2, STAGE_B = 2 * TILE_B;
  const int tid = threadIdx.x, wid = tid >> 6, lane = tid & 63, wr = wid >> 2, wc = wid & 3, fr = lane & 15, fq = lane >> 4;
  const bf16_t* Ab = A + (size_t)pm * 256 * lda;
  const bf16_t* Bb = Bt + (size_t)pn * 256 * K;
  int offA[4], offB[4];
#pragma unroll
  for (int i = 0; i < 4; ++i) { int r, c; stage_rc2(wid * 1024 + i * 8192 + lane * 16, r, c); offA[i] = r * lda + c; offB[i] = r * K + c; }
  f32x4 acc[8][4];
#pragma unroll
  for (int m = 0; m < 8; ++m)
#pragma unroll
    for (int n = 0; n < 4; ++n) acc[m][n] = (f32x4){0.f, 0.f, 0.f, 0.f};
  const int nt = K / 64;
#define G_STAGE(buf, kt) do { const int kc_ = (kt) * 64; const int ka_ = kc_ + (kc_ >= ksplit ? kjump : 0);            \
    _Pragma("unroll") for (int i = 0; i < 4; ++i) {                                                                    \
      __builtin_amdgcn_global_load_lds((const unsigned*)(Ab + offA[i] + ka_), (LAS unsigned*)(shm + (buf) * STAGE_B + wid * 1024 + i * 8192), 16, 0, 0); \
      __builtin_amdgcn_global_load_lds((const unsigned*)(Bb + offB[i] + kc_), (LAS unsigned*)(shm + (buf) * STAGE_B + TILE_B + wid * 1024 + i * 8192), 16, 0, 0); } } while (0)
  G_STAGE(0, 0); WAIT_V0(); __syncthreads();
  for (int t = 0; t < nt; ++t) {
    const int cur = t & 1;
    if (t + 1 < nt) G_STAGE(cur ^ 1, t + 1);
#pragma unroll
    for (int ks = 0; ks < 2; ++ks) {
      bf16x8 At[8], Bf[4];
#pragma unroll
      for (int m = 0; m < 8; ++m) At[m] = *(const LAS bf16x8*)(shm + cur * STAGE_B + lds_byte2(wr * 128 + m * 16 + fr, ks * 32 + fq * 8));
#pragma unroll
      for (int n = 0; n < 4; ++n) Bf[n] = *(const LAS bf16x8*)(shm + cur * STAGE_B + TILE_B + lds_byte2(wc * 64 + n * 16 + fr, ks * 32 + fq * 8));
#pragma unroll
      for (int m = 0; m < 8; ++m)
#pragma unroll
        for (int n = 0; n < 4; ++n) acc[m][n] = __builtin_amdgcn_mfma_f32_16x16x32_bf16(Bf[n], At[m], acc[m][n], 0, 0, 0);
      __builtin_amdgcn_sched_barrier(0);
    }
    WAIT_V0(); __syncthreads();
  }
#undef G_STAGE
  epi(acc, pm * 256 + wr * 128 + fr, pn, wc, fq);
}

struct EpiInProj {
  const Params& p;
  __device__ __forceinline__ void operator()(f32x4 (&acc)[8][4], int row0, int pn, int wc, int fq) const {
    bf16_t* proj = (bf16_t*)(p.ws + OFF_PROJ);
    const float2* rotA = (const float2*)(p.ws + OFF_ROT);
    const float2* rotB = rotA + 128 * 64;
    const int kind = pn >> 1;
    const int cbase = pn * 256 + (wc >> 1) * 128 + (wc & 1) * 32 + fq * 4;
#pragma unroll
    for (int m = 0; m < 8; ++m) {
      const int R = row0 + 16 * m;
      bf16_t* rowp = proj + (size_t)R * INW + cbase;
      if (kind == 1 || kind == 2) {
        const int pos = row_pos(R);
        const float sc = (kind == 2) ? 0.08838834764831845f : 1.f;
#pragma unroll
        for (int n = 0; n < 2; ++n) {
          const int j = (wc & 1) * 32 + n * 16 + fq * 4;
          f32x4 o1, o2;
#pragma unroll
          for (int r = 0; r < 4; ++r) {
            const float2 a = rotA[(pos >> 7) * 64 + j + r], b = rotB[(pos & 127) * 64 + j + r];
            const float c = a.x * b.x - a.y * b.y, s = a.y * b.x + a.x * b.y;
            const float x1 = acc[m][n][r], x2 = acc[m][n + 2][r];
            o1[r] = (x1 * c - x2 * s) * sc; o2[r] = (x1 * s + x2 * c) * sc;
          }
          *(u32x2*)(rowp + n * 16) = (u32x2){pack_bf16(o1[0], o1[1]), pack_bf16(o1[2], o1[3])};
          *(u32x2*)(rowp + 64 + n * 16) = (u32x2){pack_bf16(o2[0], o2[1]), pack_bf16(o2[2], o2[3])};
        }
      } else {
#pragma unroll
        for (int n = 0; n < 4; ++n) {
          f32x4 v = acc[m][n];
          if (kind == 4) { v[0] = silu_f(v[0]); v[1] = silu_f(v[1]); v[2] = silu_f(v[2]); v[3] = silu_f(v[3]); }
          *(u32x2*)(rowp + (n >> 1) * 64 + (n & 1) * 16) = (u32x2){pack_bf16(v[0], v[1]), pack_bf16(v[2], v[3])};
        }
      }
    }
  }
};
struct EpiOutProj {
  const Params& p;
  __device__ __forceinline__ void operator()(f32x4 (&acc)[8][4], int row0, int pn, int wc, int fq) const {
    const float* mod = (const float*)(p.ws + OFF_MOD);
    const int c0 = pn * 256 + wc * 64 + fq * 4;
    const float* gt = mod + row_batch(row0) * 6144 + 2048 + c0;
    f32x4 g[4];
#pragma unroll
    for (int n = 0; n < 4; ++n) g[n] = *(const f32x4*)(gt + n * 16);
#pragma unroll
    for (int m = 0; m < 8; ++m) {
      const int R = row0 + 16 * m;
      const float* xr = xrow(p, R) + c0;
      float* orow = p.out + (size_t)R * DM + c0;
#pragma unroll
      for (int n = 0; n < 4; ++n) { f32x4 xv = *(const f32x4*)(xr + n * 16); *(f32x4*)(orow + n * 16) = xv + g[n] * acc[m][n]; }
    }
  }
};
struct EpiMlpIn {
  const Params& p;
  __device__ __forceinline__ void operator()(f32x4 (&acc)[8][4], int row0, int pn, int wc, int fq) const {
    bf16_t* hid = (bf16_t*)(p.ws + OFF_PROJ);
    const int c0 = pn * 256 + wc * 64 + fq * 4;
#pragma unroll
    for (int m = 0; m < 8; ++m) {
      bf16_t* rowp = hid + (size_t)(row0 + 16 * m) * DFF + c0;
#pragma unroll
      for (int n = 0; n < 4; ++n) {
        f32x4 v = acc[m][n];
#pragma unroll
        for (int r = 0; r < 4; ++r) { float t = fmaxf(v[r], 0.f); v[r] = t * t; }
        *(u32x2*)(rowp + n * 16) = (u32x2){pack_bf16(v[0], v[1]), pack_bf16(v[2], v[3])};
      }
    }
  }
};
struct EpiMlpOut {
  const Params& p;
  __device__ __forceinline__ void operator()(f32x4 (&acc)[8][4], int row0, int pn, int wc, int fq) const {
    const float* mod = (const float*)(p.ws + OFF_MOD);
    const int c0 = pn * 256 + wc * 64 + fq * 4;
    const float* gt = mod + row_batch(row0) * 6144 + 5120 + c0;
    f32x4 g[4];
#pragma unroll
    for (int n = 0; n < 4; ++n) g[n] = *(const f32x4*)(gt + n * 16);
#pragma unroll
    for (int m = 0; m < 8; ++m) {
      float* orow = p.out + (size_t)(row0 + 16 * m) * DM + c0;
#pragma unroll
      for (int n = 0; n < 4; ++n) { f32x4 xv = *(const f32x4*)(orow + n * 16);
#if DBG == 3
        *(f32x4*)(orow + n * 16) = xv;
#else
        *(f32x4*)(orow + n * 16) = xv + g[n] * acc[m][n];
#endif
      }
    }
  }
};

template <class Epi>
__device__ __forceinline__ void gemm_phase(lchar* shm, const bf16_t* A, int lda, int ksplit, int kjump, const bf16_t* Bt, int K, int N, const Epi& epi) {
  const int nM = NTOK / 256, nN = N / 256;
  for (int u = blockIdx.x; u < nM * nN; u += gridDim.x) { int pm, pn; unit_map(u, nM, nN, pm, pn); gemm_unit(shm, A, lda, ksplit, kjump, Bt, K, pm, pn, epi); }
}


__device__ __forceinline__ int perm32(int rho) { const int n = rho >> 4, i = rho & 15; return 8 * (i >> 2) + 4 * n + (i & 3); }
__device__ __forceinline__ int invperm32(int w) { return 16 * ((w >> 2) & 1) + 4 * (w >> 3) + (w & 3); }
template <class Epi>
__device__ __forceinline__ void gemm_phase8(lchar* lds, const bf16_t* A, int lda, int ksplit, int kjump, const bf16_t* Bt, int K, int N, const Epi& E) {
  constexpr int HTB = 128 * 64 * 2;
  const int tid = threadIdx.x, wid = __builtin_amdgcn_readfirstlane(tid >> 6), lane = tid & 63, wr = wid >> 2, wc = wid & 3, fr = lane & 15, fq = lane >> 4;
  const int nt = K / 64, nM = NTOK / 256, nN = N / 256, nU = nM * nN, G = gridDim.x;
  unsigned voffA[2], voffB[2];
#pragma unroll
  for (int i = 0; i < 2; ++i) { int R, C; stage_rc2(tid * 16 + i * 8192, R, C); voffA[i] = (unsigned)(R * lda + C) * 2u; voffB[i] = (unsigned)(R * K + C) * 2u; }
  const size_t kstep = 128, hstepA = (size_t)128 * lda * 2, hstepB = (size_t)128 * K * 2, tstepA = 2 * hstepA, tstepB = 2 * hstepB;
  const unsigned ldsw = (unsigned)wid * 1024u;
  const int aoff = lds_byte2(wr * 64 + fr, fq * 8), boff = lds_byte2(wc * 32 + fr, fq * 8);
#define ACOLB(t) ((size_t)(((t) * 64 + (((t) * 64 >= ksplit) ? kjump : 0)) * 2))
#define P8_SA(b, h) (((b) * 2 + (h)) * HTB)
#define P8_SB(b, h) ((4 + (b) * 2 + (h)) * HTB)
#define P8_STAGE(bufoff, gbase, voff) do { _Pragma("unroll") for (int _i = 0; _i < 2; ++_i) \
    __builtin_amdgcn_global_load_lds((const unsigned*)((const char*)(gbase) + (voff)[_i]), (LAS unsigned*)(lds + (bufoff) + ldsw + _i * 8192), 16, 0, 0); } while (0)
#define P8_LDA(dst, b, h) do { _Pragma("unroll") for (int m = 0; m < 4; ++m) _Pragma("unroll") for (int k = 0; k < 2; ++k) dst[m][k] = *(const LAS bf16x8*)(lds + P8_SA(b, h) + aoff + m * 2048 + k * 1024); } while (0)
#define P8_LDB(dst, b, h) do { _Pragma("unroll") for (int n = 0; n < 2; ++n) _Pragma("unroll") for (int k = 0; k < 2; ++k) dst[n][k] = *(const LAS bf16x8*)(lds + P8_SB(b, h) + boff + n * 2048 + k * 1024); } while (0)
#define P8_MMA(ai, bj, At_, Bt_) do { __builtin_amdgcn_s_setprio(1); _Pragma("unroll") for (int m = 0; m < 4; ++m) _Pragma("unroll") for (int n = 0; n < 2; ++n) _Pragma("unroll") for (int k = 0; k < 2; ++k) \
    acc[ai][bj][m][n] = __builtin_amdgcn_mfma_f32_16x16x32_bf16(Bt_[n][k], At_[m][k], acc[ai][bj][m][n], 0, 0, 0); __builtin_amdgcn_s_setprio(0); } while (0)
#define P8_WAIT_V(n) asm volatile("s_waitcnt vmcnt(" #n ")" ::: "memory")
#define P8_WAIT_L(n) asm volatile("s_waitcnt lgkmcnt(" #n ")" ::: "memory")
#define P8_BAR __builtin_amdgcn_s_barrier()
#define P8_SCHED __builtin_amdgcn_sched_barrier(0)
  int ui = 0, cpm, cpn, npm = 0, npn = 0;
  if ((int)blockIdx.x >= nU) return;
  unit_map(blockIdx.x, nM, nN, cpm, cpn);
  f32x4 acc[2][2][4][2];
#pragma unroll
  for (int a = 0; a < 2; ++a)
#pragma unroll
    for (int b = 0; b < 2; ++b)
#pragma unroll
      for (int m = 0; m < 4; ++m)
#pragma unroll
        for (int n = 0; n < 2; ++n) acc[a][b][m][n] = (f32x4){0.f, 0.f, 0.f, 0.f};
  bf16x8 At[4][2], B0[2][2], B1[2][2];
  const char* cA = (const char*)A + (size_t)cpm * tstepA; const char* cB = (const char*)Bt + (size_t)cpn * tstepB;
  P8_STAGE(P8_SB(0, 0), cB, voffB); P8_STAGE(P8_SA(0, 0), cA + ACOLB(0), voffA); P8_STAGE(P8_SB(0, 1), cB + hstepB, voffB); P8_STAGE(P8_SA(0, 1), cA + ACOLB(0) + hstepA, voffA);
  if (wr == 1) P8_BAR;
  P8_WAIT_V(4); P8_BAR;
  P8_STAGE(P8_SB(1, 0), cB + kstep, voffB); P8_STAGE(P8_SA(1, 0), cA + ACOLB(1), voffA); P8_STAGE(P8_SB(1, 1), cB + hstepB + kstep, voffB);
  P8_WAIT_V(6); P8_BAR;
  for (;;) {
    const int nu = (ui + 1) * G + (int)blockIdx.x;
    const bool has_next = nu < nU;
    if (has_next) unit_map(nu, nM, nN, npm, npn);
    const char* nA = has_next ? (const char*)A + (size_t)npm * tstepA : cA; const char* nB = has_next ? (const char*)Bt + (size_t)npn * tstepB : cB;
    for (int t = 0; t < nt; t += 2) {
      const bool last = (t == nt - 2);
      const char* a1 = cA + ACOLB(t + 1);
      const char* a2 = last ? nA + ACOLB(0) : cA + ACOLB(t + 2); const char* b2 = last ? nB : cB + (size_t)(t + 2) * kstep;
      const char* a3 = a2 + kstep; const char* b3 = b2 + kstep;
      P8_LDB(B0, 0, 0); P8_SCHED; P8_LDA(At, 0, 0); P8_STAGE(P8_SA(1, 1), a1 + hstepA, voffA);
      P8_WAIT_L(8); P8_BAR; P8_WAIT_L(0); P8_MMA(0, 0, At, B0); P8_BAR; P8_SCHED;
      P8_LDB(B1, 0, 1); P8_STAGE(P8_SB(0, 0), b2, voffB);
      P8_BAR; P8_WAIT_L(0); P8_MMA(0, 1, At, B1); P8_BAR;
      P8_LDA(At, 0, 1); P8_STAGE(P8_SA(0, 0), a2, voffA);
      P8_BAR; P8_WAIT_L(0); P8_MMA(1, 0, At, B0); P8_BAR; P8_SCHED;
      P8_STAGE(P8_SB(0, 1), b2 + hstepB, voffB);
      P8_WAIT_V(6); P8_BAR; P8_MMA(1, 1, At, B1); P8_BAR;
      P8_LDB(B0, 1, 0); P8_SCHED; P8_LDA(At, 1, 0); P8_STAGE(P8_SA(0, 1), a2 + hstepA, voffA);
      P8_WAIT_L(8); P8_BAR; P8_WAIT_L(0); P8_MMA(0, 0, At, B0); P8_BAR; P8_SCHED;
      P8_LDB(B1, 1, 1); P8_STAGE(P8_SB(1, 0), b3, voffB);
      P8_BAR; P8_WAIT_L(0); P8_MMA(0, 1, At, B1); P8_BAR;
      P8_LDA(At, 1, 1); P8_STAGE(P8_SA(1, 0), a3, voffA);
      P8_BAR; P8_WAIT_L(0); P8_MMA(1, 0, At, B0); P8_BAR; P8_SCHED;
      P8_STAGE(P8_SB(1, 1), b3 + hstepB, voffB);
      P8_WAIT_V(6); P8_BAR; P8_MMA(1, 1, At, B1); P8_BAR;
    }
    E(acc, cpm, cpn, wr, wc, fr, fq);
    if (!has_next) break;
#pragma unroll
    for (int a = 0; a < 2; ++a)
#pragma unroll
      for (int b = 0; b < 2; ++b)
#pragma unroll
        for (int m = 0; m < 4; ++m)
#pragma unroll
          for (int n = 0; n < 2; ++n) acc[a][b][m][n] = (f32x4){0.f, 0.f, 0.f, 0.f};
    cpm = npm; cpn = npn; cA = nA; cB = nB; ++ui;
  }
  P8_WAIT_V(0);
  if (wr == 0) P8_BAR;
  P8_BAR;
#undef ACOLB
#undef P8_SA
#undef P8_SB
#undef P8_STAGE
#undef P8_LDA
#undef P8_LDB
#undef P8_MMA
#undef P8_WAIT_V
#undef P8_WAIT_L
#undef P8_BAR
#undef P8_SCHED
}

struct Epi8InProj {
  const Params& p;
  __device__ __forceinline__ void operator()(f32x4 (&acc)[2][2][4][2], int pm, int pn, int wr, int wc, int fr, int fq) const {
    bf16_t* proj = (bf16_t*)(p.ws + OFF_PROJ);
    const f32x4* rotA = (const f32x4*)(p.ws + OFF_ROT);
    const f32x4* rotB = rotA + 128 * 32;
    const int kind = pn >> 1;
    const int head = wc >> 1, j0 = (wc & 1) * 32 + 8 * fq;
#pragma unroll
    for (int ai = 0; ai < 2; ++ai) {
      const int R0 = pm * 256 + ai * 128 + wr * 64 + fr;
      if (kind == 1 || kind == 2) {
        const float sc = (kind == 2) ? 0.08838834764831845f : 1.f;
        const int pos0 = row_pos(R0);
        f32x4 ra[4], rbb[2][4];
#pragma unroll
        for (int q = 0; q < 4; ++q) ra[q] = rotA[((pos0 >> 7) * 64 + j0) / 2 + q];
#pragma unroll
        for (int q = 0; q < 4; ++q) rbb[0][q] = rotB[((pos0 & 127) * 64 + j0) / 2 + q];
#pragma unroll
        for (int m = 0; m < 4; ++m) {
          const int R = R0 + 16 * m;
          if (m < 3) {
#pragma unroll
            for (int q = 0; q < 4; ++q) rbb[(m + 1) & 1][q] = rotB[(((pos0 + 16 * (m + 1)) & 127) * 64 + j0) / 2 + q];
          }
          const f32x4 (&rb)[4] = rbb[m & 1];
          float o1[8], o2[8];
#pragma unroll
          for (int e = 0; e < 8; ++e) {
            const float ca = ra[e >> 1][(e & 1) * 2], sa = ra[e >> 1][(e & 1) * 2 + 1], cb = rb[e >> 1][(e & 1) * 2], sb = rb[e >> 1][(e & 1) * 2 + 1];
            const float c = ca * cb - sa * sb, s = sa * cb + ca * sb;
            const float x1 = acc[ai][0][m][e >> 2][e & 3], x2 = acc[ai][1][m][e >> 2][e & 3];
            o1[e] = (x1 * c - x2 * s) * sc; o2[e] = (x1 * s + x2 * c) * sc;
          }
          bf16_t* rowp = proj + (size_t)R * INW + pn * 256 + head * 128 + j0;
          *(u32x4*)(rowp) = (u32x4){pack_bf16(o1[0], o1[1]), pack_bf16(o1[2], o1[3]), pack_bf16(o1[4], o1[5]), pack_bf16(o1[6], o1[7])};
          *(u32x4*)(rowp + 64) = (u32x4){pack_bf16(o2[0], o2[1]), pack_bf16(o2[2], o2[3]), pack_bf16(o2[4], o2[5]), pack_bf16(o2[6], o2[7])};
        }
      } else {
#pragma unroll
        for (int m = 0; m < 4; ++m) {
          bf16_t* rowp = proj + (size_t)(R0 + 16 * m) * INW + pn * 256 + head * 128 + j0;
#pragma unroll
          for (int bj = 0; bj < 2; ++bj) {
            f32x4 v0 = acc[ai][bj][m][0], v1 = acc[ai][bj][m][1];
            if (kind == 4) {
#pragma unroll
              for (int r = 0; r < 4; ++r) { v0[r] = silu_f(v0[r]); v1[r] = silu_f(v1[r]); }
            }
            *(u32x4*)(rowp + bj * 64) = (u32x4){pack_bf16(v0[0], v0[1]), pack_bf16(v0[2], v0[3]), pack_bf16(v1[0], v1[1]), pack_bf16(v1[2], v1[3])};
          }
        }
      }
    }
  }
};
template <int GT_OFF, bool INPLACE>
struct Epi8Resid {
  const Params& p;
  __device__ __forceinline__ void operator()(f32x4 (&acc)[2][2][4][2], int pm, int pn, int wr, int wc, int fr, int fq) const {
    const float* mod = (const float*)(p.ws + OFF_MOD);
    const int c0 = pn * 256 + wc * 32 + fq * 4;
    const float* gt = mod + row_batch(pm * 256) * 6144 + GT_OFF + c0;
    f32x4 g[2][2];
#pragma unroll
    for (int bj = 0; bj < 2; ++bj)
#pragma unroll
      for (int n = 0; n < 2; ++n) g[bj][n] = *(const f32x4*)(gt + bj * 128 + n * 16);
#pragma unroll
    for (int ai = 0; ai < 2; ++ai)
#pragma unroll
      for (int m = 0; m < 4; ++m) {
        const int R = pm * 256 + ai * 128 + wr * 64 + m * 16 + fr;
        const float* xr = (INPLACE ? (const float*)(p.out + (size_t)R * DM) : xrow(p, R)) + c0;
        float* orow = p.out + (size_t)R * DM + c0;
#pragma unroll
        for (int bj = 0; bj < 2; ++bj)
#pragma unroll
          for (int n = 0; n < 2; ++n) { const f32x4 xv = *(const f32x4*)(xr + bj * 128 + n * 16); *(f32x4*)(orow + bj * 128 + n * 16) = xv + g[bj][n] * acc[ai][bj][m][n]; }
      }
  }
};
struct Epi8OutProj {
  const Params& p;
  __device__ __forceinline__ void operator()(f32x4 (&acc)[2][2][4][2], int pm, int pn, int wr, int wc, int fr, int fq) const {
    const float* mod = (const float*)(p.ws + OFF_MOD) + row_batch(pm * 256) * 6144;
    const float* xbase = xrow(p, pm * 256);
    bf16_t* x1base = (bf16_t*)((char*)p.out + OUT_H) + (size_t)pm * 256 * DM;
    bf16_t* h2base = (bf16_t*)(p.ws + OFF_H2) + (size_t)pm * 256 * DM;
    float* ssq = (float*)(p.ws + OFF_SSQ) + pm * 256;
    const int c0 = pn * 256 + wc * 32 + fq * 8;
    const unsigned lo = (unsigned)((wr * 64 + fr) * DM + c0);
    float ssv[8];
#pragma unroll
    for (int gi = 0; gi < 8; ++gi) ssv[gi] = 0.f;
#pragma unroll
    for (int bj = 0; bj < 2; ++bj) {
      f32x4 g[2], a2[2];
#pragma unroll
      for (int n = 0; n < 2; ++n) {
        const int c = c0 + bj * 128 + n * 4;
        g[n] = *(const f32x4*)(mod + 2048 + c);
        a2[n] = *(const f32x4*)(p.norm_mlp + c) * (*(const f32x4*)(mod + 4096 + c) + 1.f);
      }
      f32x4 xv[2][2];
#pragma unroll
      for (int n = 0; n < 2; ++n) xv[0][n] = __builtin_nontemporal_load((const f32x4*)(xbase + lo + (unsigned)(bj * 128 + n * 4)));
#pragma unroll
      for (int gi = 0; gi < 8; ++gi) {
        const int ai = gi >> 2, m = gi & 3;
        if (gi < 7) {
#pragma unroll
          for (int n = 0; n < 2; ++n) xv[(gi + 1) & 1][n] = __builtin_nontemporal_load((const f32x4*)(xbase + lo + (unsigned)((((gi + 1) >> 2) * 128 + ((gi + 1) & 3) * 16) * DM + bj * 128 + n * 4)));
        }
        const unsigned ro = lo + (unsigned)((ai * 128 + m * 16) * DM + bj * 128);
        const f32x4 v0 = xv[gi & 1][0] + g[0] * acc[ai][bj][m][0], v1 = xv[gi & 1][1] + g[1] * acc[ai][bj][m][1];
        *(u32x4*)(x1base + ro) = (u32x4){pack_bf16(v0[0], v0[1]), pack_bf16(v0[2], v0[3]), pack_bf16(v1[0], v1[1]), pack_bf16(v1[2], v1[3])};
        ssv[gi] += (v0[0] * v0[0] + v0[1] * v0[1] + v0[2] * v0[2] + v0[3] * v0[3]) + (v1[0] * v1[0] + v1[1] * v1[1] + v1[2] * v1[2] + v1[3] * v1[3]);
        const f32x4 h0 = v0 * a2[0], h1 = v1 * a2[1];
        *(u32x4*)(h2base + ro) = (u32x4){pack_bf16(h0[0], h0[1]), pack_bf16(h0[2], h0[3]), pack_bf16(h1[0], h1[1]), pack_bf16(h1[2], h1[3])};
      }
    }
#pragma unroll
    for (int gi = 0; gi < 8; ++gi) {
      float ss = ssv[gi];
      ss += __shfl_xor(ss, 16); ss += __shfl_xor(ss, 32);
      if (fq == 0) atomicAdd(ssq + wr * 64 + fr + (gi >> 2) * 128 + (gi & 3) * 16, ss);
    }
  }
};
struct Epi8MlpOut {
  const Params& p;
  __device__ __forceinline__ void operator()(f32x4 (&acc)[2][2][4][2], int pm, int pn, int wr, int wc, int fr, int fq) const {
    const float* mod = (const float*)(p.ws + OFF_MOD);
    const int c0 = pn * 256 + wc * 32 + fq * 8;
    const float* gt = mod + row_batch(pm * 256) * 6144 + 5120 + c0;
    const bf16_t* x1base = (const bf16_t*)((const char*)p.out + OUT_H) + (size_t)pm * 256 * DM;
    bf16_t* x2base = (bf16_t*)(p.ws + OFF_H2) + (size_t)pm * 256 * DM;
    const unsigned lo = (unsigned)((wr * 64 + fr) * DM + c0);
    f32x4 g[2][2];
#pragma unroll
    for (int bj = 0; bj < 2; ++bj)
#pragma unroll
      for (int n = 0; n < 2; ++n) g[bj][n] = *(const f32x4*)(gt + bj * 128 + n * 4);
    u32x4 xv[2][2];
#pragma unroll
    for (int bj = 0; bj < 2; ++bj) xv[0][bj] = __builtin_nontemporal_load((const u32x4*)(x1base + lo + (unsigned)(bj * 128)));
#pragma unroll
    for (int gi = 0; gi < 8; ++gi) {
      const int ai = gi >> 2, m = gi & 3;
      if (gi < 7) {
#pragma unroll
        for (int bj = 0; bj < 2; ++bj) xv[(gi + 1) & 1][bj] = __builtin_nontemporal_load((const u32x4*)(x1base + lo + (unsigned)((((gi + 1) >> 2) * 128 + ((gi + 1) & 3) * 16) * DM + bj * 128)));
      }
      const unsigned ro = lo + (unsigned)((ai * 128 + m * 16) * DM);
#pragma unroll
      for (int bj = 0; bj < 2; ++bj) {
        const u32x4 xb = xv[gi & 1][bj];
        const f32x4 x0 = (f32x4){bf_lo(xb[0]), bf_hi(xb[0]), bf_lo(xb[1]), bf_hi(xb[1])}, x1 = (f32x4){bf_lo(xb[2]), bf_hi(xb[2]), bf_lo(xb[3]), bf_hi(xb[3])};
        const f32x4 v0 = x0 + g[bj][0] * acc[ai][bj][m][0], v1 = x1 + g[bj][1] * acc[ai][bj][m][1];
        *(u32x4*)(x2base + ro + bj * 128) = (u32x4){pack_bf16(v0[0], v0[1]), pack_bf16(v0[2], v0[3]), pack_bf16(v1[0], v1[1]), pack_bf16(v1[2], v1[3])};
      }
    }
  }
};
struct Epi8MlpIn {
  const Params& p;
  __device__ __forceinline__ void operator()(f32x4 (&acc)[2][2][4][2], int pm, int pn, int wr, int wc, int fr, int fq) const {
    bf16_t* hid = (bf16_t*)(p.ws + OFF_PROJ);
    const float* ssq = (const float*)(p.ws + OFF_SSQ);
    const int c0 = pn * 256 + wc * 64 + fq * 8;
    const float* b2 = (const float*)(p.ws + OFF_BIAS2) + row_batch(pm * 256) * DFF + c0;
    f32x4 bias[2][2];
#pragma unroll
    for (int bj = 0; bj < 2; ++bj)
#pragma unroll
      for (int n = 0; n < 2; ++n) bias[bj][n] = *(const f32x4*)(b2 + bj * 32 + n * 4);
    float rsv[8];
#pragma unroll
    for (int gi = 0; gi < 8; ++gi) rsv[gi] = ssq[pm * 256 + (gi >> 2) * 128 + wr * 64 + (gi & 3) * 16 + fr];
#pragma unroll
    for (int ai = 0; ai < 2; ++ai)
#pragma unroll
      for (int m = 0; m < 4; ++m) {
        const int R = pm * 256 + ai * 128 + wr * 64 + m * 16 + fr;
        const float rs = rsqrtf(rsv[ai * 4 + m] * (1.f / 1024.f) + 1e-6f);
        bf16_t* rowp = hid + (size_t)R * DFF + c0;
#pragma unroll
        for (int bj = 0; bj < 2; ++bj) {
          float v[8];
#pragma unroll
          for (int e = 0; e < 8; ++e) { const float t = fmaxf(acc[ai][bj][m][e >> 2][e & 3] * rs + bias[bj][e >> 2][e & 3], 0.f); v[e] = t * t; }
          __builtin_nontemporal_store((u32x4){pack_bf16(v[0], v[1]), pack_bf16(v[2], v[3]), pack_bf16(v[4], v[5]), pack_bf16(v[6], v[7])}, (u32x4*)(rowp + bj * 32));
        }
      }
  }
};

__device__ __forceinline__ int t_sw(int row) { return ((row & 3) << 2) | ((row >> 2) & 3); }
__device__ __forceinline__ int t_off(int row, int ch) { return 256 * row + 16 * (ch ^ t_sw(row)); }

__device__ __forceinline__ void tile_glds(lchar* dst, const bf16_t* src, size_t ld) {
  const int tid = threadIdx.x, wid = tid >> 6;
#pragma unroll
  for (int i = 0; i < 4; ++i) {
    const int L = i * 512 + tid, row = L >> 4, ch = (L & 15) ^ t_sw(row);
    __builtin_amdgcn_global_load_lds((const unsigned*)(src + (size_t)row * ld + ch * 8), (LAS unsigned*)(dst + (i * 512 + wid * 64) * 16), 16, 0, 0);
  }
}
__device__ __forceinline__ bf16x8 frag_row(const lchar* tile, int rbase, int ks, int fr, int fq) {
  return *(const LAS bf16x8*)(tile + t_off(rbase + fr, 4 * ks + fq));
}
__device__ __forceinline__ bf16x8 frag_tr(const lchar* tile, int c, int ks, int lane) {
  const int g = lane >> 4, q = (lane & 15) >> 2, pp = lane & 3;
  const int r0 = 32 * ks + 8 * g + q;
  s16x4 lo = __builtin_amdgcn_ds_read_tr16_b64_v4i16((LAS s16x4*)(tile + t_off(r0, 2 * c + (pp >> 1)) + 8 * (pp & 1)));
  s16x4 hi = __builtin_amdgcn_ds_read_tr16_b64_v4i16((LAS s16x4*)(tile + t_off(r0 + 4, 2 * c + (pp >> 1)) + 8 * (pp & 1)));
  return (bf16x8){lo[0], lo[1], lo[2], lo[3], hi[0], hi[1], hi[2], hi[3]};
}
template <bool ATR, bool BTR>
__device__ __forceinline__ void mm128(f32x4 (&acc)[2][4], const lchar* At, const lchar* Bt) {
  const int tid = threadIdx.x, wid = tid >> 6, lane = tid & 63, wr = wid >> 1, wc = wid & 1, fr = lane & 15, fq = lane >> 4;
  bf16x8 a[2][2], b[2][4];
#pragma unroll
  for (int m = 0; m < 2; ++m) a[0][m] = ATR ? frag_tr(At, wr * 2 + m, 0, lane) : frag_row(At, wr * 32 + m * 16, 0, fr, fq);
#pragma unroll
  for (int n = 0; n < 4; ++n) b[0][n] = BTR ? frag_tr(Bt, wc * 4 + n, 0, lane) : frag_row(Bt, wc * 64 + n * 16, 0, fr, fq);
#pragma unroll
  for (int ks = 0; ks < 4; ++ks) {
    const int c = ks & 1, d = c ^ 1;
    if (ks < 3) {
#pragma unroll
      for (int m = 0; m < 2; ++m) a[d][m] = ATR ? frag_tr(At, wr * 2 + m, ks + 1, lane) : frag_row(At, wr * 32 + m * 16, ks + 1, fr, fq);
#pragma unroll
      for (int n = 0; n < 4; ++n) b[d][n] = BTR ? frag_tr(Bt, wc * 4 + n, ks + 1, lane) : frag_row(Bt, wc * 64 + n * 16, ks + 1, fr, fq);
    }
#pragma unroll
    for (int m = 0; m < 2; ++m)
#pragma unroll
      for (int n = 0; n < 4; ++n) acc[m][n] = __builtin_amdgcn_mfma_f32_16x16x32_bf16(b[c][n], a[c][m], acc[m][n], 0, 0, 0);
    __builtin_amdgcn_sched_barrier(0);
  }
}
__device__ __forceinline__ void zero_acc(f32x4 (&acc)[2][4]) {
#pragma unroll
  for (int m = 0; m < 2; ++m)
#pragma unroll
    for (int n = 0; n < 4; ++n) acc[m][n] = (f32x4){0.f, 0.f, 0.f, 0.f};
}
__device__ __forceinline__ void acc_to_image(lchar* tile, const f32x4 (&acc)[2][4]) {
  const int tid = threadIdx.x, wid = tid >> 6, lane = tid & 63, wr = wid >> 1, wc = wid & 1, fr = lane & 15, fq = lane >> 4;
#pragma unroll
  for (int m = 0; m < 2; ++m)
#pragma unroll
    for (int n = 0; n < 4; ++n) {
      const int row = wr * 32 + m * 16 + fr, col = wc * 64 + n * 16 + fq * 4;
      *(LAS u32x2*)(tile + t_off(row, col >> 3) + (col & 7) * 2) = (u32x2){pack_bf16(acc[m][n][0], acc[m][n][1]), pack_bf16(acc[m][n][2], acc[m][n][3])};
    }
}

__device__ void transpose_item(const Params& p, lchar* shm, int t) {
  constexpr int T_IN = 16 * 10, T_OUT = 16 * 4, T_1 = 16 * 16;
  const int tid = threadIdx.x; char* ws = p.ws;
  const float* src; bf16_t* dst; int K, N, perm = 0;
  if (t < T_IN) { src = p.w_in; dst = (bf16_t*)(ws + OFF_WIN); K = 1024; N = INW; perm = 1; }
  else if ((t -= T_IN) < T_OUT) { src = p.w_out; dst = (bf16_t*)(ws + OFF_WOUT); K = 1024; N = 1024; perm = 2; }
  else if ((t -= T_OUT) < T_1) { src = p.w_mlp_in; dst = (bf16_t*)(ws + OFF_W1); K = 1024; N = DFF; perm = 3; }
  else { t -= T_1; src = p.w_mlp_out; dst = (bf16_t*)(ws + OFF_W2); K = DFF; N = 1024; perm = 2; }
  const int nNt = N / 256, k0 = (t / nNt) * 64, n0 = (t % nNt) * 256;
  LAS float* tl = (LAS float*)shm;
  f32x4 ld[8];
#pragma unroll
  for (int i = 0; i < 8; ++i) { const int kk = i * 8 + (tid >> 6), nn = (tid & 63) * 4; ld[i] = *(const f32x4*)(src + (size_t)(k0 + kk) * N + n0 + nn); }
#pragma unroll
  for (int i = 0; i < 8; ++i) { const int kk = i * 8 + (tid >> 6), nn = (tid & 63) * 4; tl[kk * 257 + nn] = ld[i][0]; tl[kk * 257 + nn + 1] = ld[i][1]; tl[kk * 257 + nn + 2] = ld[i][2]; tl[kk * 257 + nn + 3] = ld[i][3]; }
  __syncthreads();
#pragma unroll
  for (int q = 0; q < 4; ++q) {
    const int nn = q * 64 + (tid >> 3), kc = tid & 7;
    float v[8];
#pragma unroll
    for (int e = 0; e < 8; ++e) v[e] = tl[(kc * 8 + e) * 257 + nn];
    int nrow = n0 + nn;
    if (perm) {
      const int a = nrow & 255, ag = a >> 5, w = a & 31;
      const int rho = 16 * ((w >> 2) & 1) + 4 * (w >> 3) + (w & 3);
      const int gi = (perm == 1) ? (((ag >> 1) & 1) * 4 + (ag >> 2) * 2 + (ag & 1)) : (perm == 3 ? ((ag & 1) * 4 + (ag >> 1)) : ag);
      nrow = (nrow & ~255) + gi * 32 + rho;
    }
    *(u32x4*)(dst + (size_t)nrow * K + k0 + kc * 8) = (u32x4){pack_bf16(v[0], v[1]), pack_bf16(v[2], v[3]), pack_bf16(v[4], v[5]), pack_bf16(v[6], v[7])};
  }
  __syncthreads();
}
__device__ void late_transposes(const Params& p, lchar* shm) {
  const int half = gridDim.x >> 1;
  if ((int)blockIdx.x >= half) for (int t = 160 + (int)blockIdx.x - half; t < 160 + 576; t += (int)gridDim.x - half) transpose_item(p, shm, t);
}

__device__ void phase0a(const Params& p, lchar* shm) {
  const int tid = threadIdx.x, wid = tid >> 6, lane = tid & 63;
  const int gtid = (gridDim.x - 1 - blockIdx.x) * 512 + tid, gsz = gridDim.x * 512;
  char* ws = p.ws;
  {
    float2* rot = (float2*)(ws + OFF_ROT);
    bf16_t* ft = (bf16_t*)(ws + OFF_FTAB);
    float2* twp = (float2*)(ws + OFF_TWP);
    float2* tws = (float2*)(ws + OFF_TWS);
    float* gp = (float*)(ws + OFF_GPOW);
    constexpr int T0 = 16384, T1 = T0 + 5 * 16384, T2 = T1 + 16384, T3 = T2 + 2048, T4 = T3 + 2 * 4 * 132, T5 = T4 + NTOK;
    const int nthr = gsz > 160 * 512 ? 160 * 512 : gsz;
    if (gtid < nthr) for (int w = gtid; w < T5; w += nthr) {
      if (w < T0) {
        const int idx = w, which = idx >> 13, e = idx & 8191, a = e >> 6, j = e & 63;
        double inv = 1.0; for (int t = 0; t < j; ++t) inv *= 0.8659643233600653;
        const double ang = (which ? (double)a : 128.0 * (double)a) * inv;
        double s_, c_; sincos_d(ang, s_, c_);
        rot[idx] = make_float2((float)c_, (float)s_);
      } else if (w < T1) {
        const int idx = w - T0, t = idx >> 14, e = idx & 16383, row = e >> 7, col = e & 127;
        double s_, c_; float v;
        if (t < 3) { sincos_d(6.283185307179586476925 * (double)((row * col) & 127) / 128.0, s_, c_); v = (t == 0) ? (float)c_ : (t == 1 ? (float)(-s_) : (float)s_); }
        else { sincos_d(6.283185307179586476925 * (double)(((row & 15) * (col & 15)) & 15) / 16.0, s_, c_); v = ((row >> 4) == (col >> 4)) ? (t == 3 ? (float)c_ : (float)s_) : 0.f; }
        ft[idx] = (bf16_t)(pack_bf16(v, 0.f) & 0xffff);
      } else if (w < T2) {
        const int idx = w - T1; double s_, c_; sincos_d(6.283185307179586476925 * (double)idx / 16384.0, s_, c_);
        const double nrm = 1.0 / sqrt(16384.0 * 128.0);
        twp[idx] = make_float2((float)(c_ * nrm), (float)(-s_ * nrm));
      } else if (w < T3) {
        const int idx = w - T2; double s_, c_; sincos_d(6.283185307179586476925 * (double)idx / 2048.0, s_, c_);
        tws[idx] = make_float2((float)(c_ / 512.0), (float)(-s_ / 512.0));
      } else if (w < T4) {
        const int idx = w - T3, dir = idx / (4 * 132), h = (idx / 132) & 3, t = idx % 132;
        double e2 = 1.0 / 32.0; for (int i = 0; i < h; ++i) e2 *= 0.5;
        if (dir) e2 *= 0.70710678118654752440;
        const double g = 1.0 - e2; double v = 1.0; for (int i = 0; i < t; ++i) v *= g;
        gp[idx] = (float)v;
      } else {
        ((float*)(ws + OFF_SSQ))[w - T4] = 0.f;
      }
    }
  }
  {
    LAS f32x2* ctab = (LAS f32x2*)shm;
    if (tid < 128) { double s, c; sincos_d(6.283185307179586476925 * (double)tid / 128.0, s, c); ctab[tid] = (f32x2){(float)c, (float)s}; }
    __syncthreads();
    bf16_t* mt = (bf16_t*)(ws + OFF_MTAB);
    for (int idx = gtid; idx < 65536; idx += gsz) {
      const int g = idx >> 14, c = (idx >> 7) & 127, d = idx & 127;
      const float* W = p.w_fnet + (size_t)g * 16384 + d;
      float mr = 0.f, mi = 0.f;
#pragma unroll 32
      for (int cc = 0; cc < 128; ++cc) { const float w = W[cc * 128]; const f32x2 t = ctab[(c * cc) & 127]; mr += t.x * w; mi -= t.y * w; }
      const int drow = (d & ~31) + invperm32(invperm32(d & 31));
      mt[(size_t)(g * 2 + 0) * 16384 + drow * 128 + c] = (bf16_t)(pack_bf16(mr, 0.f) & 0xffff);
      mt[(size_t)(g * 2 + 1) * 16384 + drow * 128 + c] = (bf16_t)(pack_bf16(mi, 0.f) & 0xffff);
    }
    __syncthreads();
  }
  constexpr int N_GEMV = 96, T_IN = 16 * 10;
  for (int item = blockIdx.x; item < N_GEMV + T_IN; item += gridDim.x) {
    if (item < N_GEMV) {
      LAS float* sc = (LAS float*)shm;
      LAS float* red = (LAS float*)(shm + 49152);
      for (int i = tid; i < NB * 1024; i += 512) { const int b = i >> 10, k = i & 1023; const float v = b < 2 ? p.c_prompt[b * 1024 + k] : p.c_sample[(b - 2) * 1024 + k]; sc[k * 12 + b] = silu_f(v); }
      __syncthreads();
      const int col = item * 64 + lane;
      float a[NB];
#pragma unroll
      for (int b = 0; b < NB; ++b) a[b] = 0.f;
      for (int k0 = wid * 128; k0 < wid * 128 + 128; k0 += 32) {
        float w[32];
#pragma unroll
        for (int u = 0; u < 32; ++u) w[u] = p.ada_w[(size_t)(k0 + u) * 6144 + col];
#pragma unroll
        for (int u = 0; u < 32; ++u) {
          const f32x4 s0 = *(const LAS f32x4*)(sc + (k0 + u) * 12), s1 = *(const LAS f32x4*)(sc + (k0 + u) * 12 + 4), s2 = *(const LAS f32x4*)(sc + (k0 + u) * 12 + 8);
          a[0] += s0[0] * w[u]; a[1] += s0[1] * w[u]; a[2] += s0[2] * w[u]; a[3] += s0[3] * w[u];
          a[4] += s1[0] * w[u]; a[5] += s1[1] * w[u]; a[6] += s1[2] * w[u]; a[7] += s1[3] * w[u];
          a[8] += s2[0] * w[u]; a[9] += s2[1] * w[u];
        }
      }
#pragma unroll
      for (int b = 0; b < NB; ++b) red[(wid * NB + b) * 64 + lane] = a[b];
      __syncthreads();
      for (int i = tid; i < NB * 64; i += 512) {
        const int b = i >> 6, l = i & 63; float s = p.ada_b[item * 64 + l];
        for (int w = 0; w < 8; ++w) s += red[(w * NB + b) * 64 + l];
        ((float*)(ws + OFF_MOD))[b * 6144 + item * 64 + l] = s;
      }
      __syncthreads();
    } else {
      transpose_item(p, shm, item - N_GEMV);
    }
  }
}

__device__ void bias2_items(const Params& p, lchar* shm) {
  const int tid = threadIdx.x, wid = tid >> 6, lane = tid & 63;
  const float* mod = (const float*)(p.ws + OFF_MOD);
  const int first = (int)gridDim.x > 64 ? (int)gridDim.x - 64 : 0;
  for (int item = (int)blockIdx.x - first; item >= 0 && item < 64; item += (int)gridDim.x - first) {
    LAS float* sc = (LAS float*)shm;
    LAS float* red = (LAS float*)(shm + 40960);
    for (int i = tid; i < NB * 1024; i += 512) sc[i] = mod[(i >> 10) * 6144 + 3072 + (i & 1023)];
    __syncthreads();
    const int col = item * 64 + lane;
    float a[NB];
#pragma unroll
    for (int b = 0; b < NB; ++b) a[b] = 0.f;
    for (int k = wid * 128; k < wid * 128 + 128; ++k) {
      const float w = p.w_mlp_in[(size_t)k * DFF + col];
#pragma unroll
      for (int b = 0; b < NB; ++b) a[b] += sc[b * 1024 + k] * w;
    }
#pragma unroll
    for (int b = 0; b < NB; ++b) red[(wid * NB + b) * 64 + lane] = a[b];
    __syncthreads();
    for (int i = tid; i < NB * 64; i += 512) {
      const int b = i >> 6, l = i & 63; float sum = 0.f;
      for (int w = 0; w < 8; ++w) sum += red[(w * NB + b) * 64 + l];
      ((float*)(p.ws + OFF_BIAS2))[b * DFF + item * 64 + l] = sum;
    }
    __syncthreads();
  }
}

__device__ __forceinline__ void row_finish(const Params& p, int which, int R, const f32x4 (&v)[4], int lane) {
  const float* mod = (const float*)(p.ws + OFF_MOD);
  float ss = 0.f;
#pragma unroll
  for (int i = 0; i < 4; ++i) ss += v[i][0] * v[i][0] + v[i][1] * v[i][1] + v[i][2] * v[i][2] + v[i][3] * v[i][3];
#pragma unroll
  for (int o = 32; o > 0; o >>= 1) ss += __shfl_xor(ss, o);
  const float rs = rsqrtf(ss * (1.f / 1024.f) + 1e-6f);
  if (which == 2) {
#pragma unroll
    for (int i = 0; i < 4; ++i) { const f32x4 g = *(const f32x4*)(p.norm_final + i * 256 + lane * 4); __builtin_nontemporal_store(v[i] * rs * g, (f32x4*)(p.out + (size_t)R * DM + i * 256 + lane * 4)); }
  } else {
    const float* md = mod + row_batch(R) * 6144 + (which ? 3072 : 0);
    const float* gain = which ? p.norm_mlp : p.norm_mix;
    bf16_t* dst = which ? (bf16_t*)(p.ws + OFF_H2) : (bf16_t*)((char*)p.out + OUT_H);
#pragma unroll
    for (int i = 0; i < 4; ++i) {
      const int col = i * 256 + lane * 4;
      const f32x4 g = *(const f32x4*)(gain + col), sh = *(const f32x4*)(md + col), sc = *(const f32x4*)(md + 1024 + col);
      const f32x4 y = v[i] * rs * g * (sc + 1.f) + sh;
      *(u32x2*)(dst + (size_t)R * DM + col) = (u32x2){pack_bf16(y[0], y[1]), pack_bf16(y[2], y[3])};
    }
  }
}
__device__ void rows_phase(const Params& p, int which) {
  const int tid = threadIdx.x, lane = tid & 63;
  const int stride = gridDim.x * 8;
  for (int R0 = blockIdx.x * 8 + (tid >> 6); R0 < NTOK; R0 += 2 * stride) {
    const int Ra = (which == 2) ? NTOK - 1 - R0 : R0;
    const int R1 = R0 + stride; const bool two = R1 < NTOK;
    const int Rb = (which == 2) ? NTOK - 1 - R1 : R1;
    f32x4 va[4], vb[4];
    if (which == 2) {
      const bf16_t* x2 = (const bf16_t*)(p.ws + OFF_H2);
      u32x2 ua[4], ub[4];
#pragma unroll
      for (int i = 0; i < 4; ++i) ua[i] = __builtin_nontemporal_load((const u32x2*)(x2 + (size_t)Ra * DM + i * 256 + lane * 4));
#pragma unroll
      for (int i = 0; i < 4; ++i) ub[i] = __builtin_nontemporal_load((const u32x2*)(x2 + (size_t)(two ? Rb : Ra) * DM + i * 256 + lane * 4));
#pragma unroll
      for (int i = 0; i < 4; ++i) { va[i] = (f32x4){bf_lo(ua[i][0]), bf_hi(ua[i][0]), bf_lo(ua[i][1]), bf_hi(ua[i][1])}; vb[i] = (f32x4){bf_lo(ub[i][0]), bf_hi(ub[i][0]), bf_lo(ub[i][1]), bf_hi(ub[i][1])}; }
    } else {
      const float* sa = which ? p.out + (size_t)Ra * DM : xrow(p, Ra);
      const float* sb = two ? (which ? p.out + (size_t)Rb * DM : xrow(p, Rb)) : sa;
#pragma unroll
      for (int i = 0; i < 4; ++i) va[i] = __builtin_nontemporal_load((const f32x4*)(sa + i * 256 + lane * 4));
#pragma unroll
      for (int i = 0; i < 4; ++i) vb[i] = __builtin_nontemporal_load((const f32x4*)(sb + i * 256 + lane * 4));
    }
    row_finish(p, which, Ra, va, lane);
    if (two) row_finish(p, which, Rb, vb, lane);
  }
}

__device__ __forceinline__ void tile_load_regs(u32x4 (&v)[4], const bf16_t* src, size_t ld) {
  const int tid = threadIdx.x;
#pragma unroll
  for (int i = 0; i < 4; ++i) { const int L = i * 512 + tid, row = L >> 4, ch = L & 15; v[i] = *(const u32x4*)(src + (size_t)row * ld + ch * 8); }
}
__device__ __forceinline__ void tile_load_regs_nt(u32x4 (&v)[4], const bf16_t* src, size_t ld) {
  const int tid = threadIdx.x;
#pragma unroll
  for (int i = 0; i < 4; ++i) { const int L = i * 512 + tid, row = L >> 4, ch = L & 15; v[i] = __builtin_nontemporal_load((const u32x4*)(src + (size_t)row * ld + ch * 8)); }
}
__device__ __forceinline__ void tile_store_regs(lchar* dst, const u32x4 (&v)[4]) {
  const int tid = threadIdx.x;
#pragma unroll
  for (int i = 0; i < 4; ++i) { const int L = i * 512 + tid, row = L >> 4, ch = L & 15; *(LAS u32x4*)(dst + t_off(row, ch)) = v[i]; }
}
__device__ __forceinline__ void load_afrags(bf16x8 (&a)[2][4], const bf16_t* tab) {
  const int tid = threadIdx.x, wid = tid >> 6, lane = tid & 63, wr = wid >> 1, fr = lane & 15, fq = lane >> 4;
#pragma unroll
  for (int m = 0; m < 2; ++m)
#pragma unroll
    for (int ks = 0; ks < 4; ++ks) a[m][ks] = *(const bf16x8*)(tab + (wr * 32 + m * 16 + fr) * 128 + ks * 32 + fq * 8);
}
template <bool BTR>
__device__ __forceinline__ void mm128_areg(f32x4 (&acc)[2][4], const bf16x8 (&a)[2][4], const lchar* Bt) {
  const int tid = threadIdx.x, wid = tid >> 6, lane = tid & 63, wc = wid & 1, fr = lane & 15, fq = lane >> 4;
  bf16x8 b[2][4];
#pragma unroll
  for (int n = 0; n < 4; ++n) b[0][n] = BTR ? frag_tr(Bt, wc * 4 + n, 0, lane) : frag_row(Bt, wc * 64 + n * 16, 0, fr, fq);
#pragma unroll
  for (int ks = 0; ks < 4; ++ks) {
    const int c = ks & 1, d = c ^ 1;
    if (ks < 3) {
#pragma unroll
      for (int n = 0; n < 4; ++n) b[d][n] = BTR ? frag_tr(Bt, wc * 4 + n, ks + 1, lane) : frag_row(Bt, wc * 64 + n * 16, ks + 1, fr, fq);
    }
#pragma unroll
    for (int m = 0; m < 2; ++m)
#pragma unroll
      for (int n = 0; n < 4; ++n) acc[m][n] = __builtin_amdgcn_mfma_f32_16x16x32_bf16(b[c][n], a[m][ks], acc[m][n], 0, 0, 0);
    __builtin_amdgcn_sched_barrier(0);
  }
}

struct FftAItem { const bf16_t* src; size_t ld; const float2* tw; size_t tbase; int s2, ns2; };
__device__ __forceinline__ FftAItem ffta_item(const Params& p, int g, int j) {
  FftAItem it; const bf16_t* proj = (const bf16_t*)(p.ws + OFF_PROJ);
  if (j < 256) { const int b = j >> 7; it.s2 = j & 127; it.ns2 = 128; it.src = proj + (size_t)(b * 16384 + it.s2) * INW + g * 128; it.ld = (size_t)128 * INW;
    it.tw = (const float2*)(p.ws + OFF_TWP); it.tbase = (size_t)(b * 4 + g) * 128 * 128 * 128; }
  else { const int jj = j - 256, b = jj >> 4; it.s2 = jj & 15; it.ns2 = 16; it.src = proj + (size_t)(PROWS + b * 2048 + it.s2) * INW + g * 128; it.ld = (size_t)16 * INW;
    it.tw = (const float2*)(p.ws + OFF_TWS); it.tbase = (size_t)16777216 + (size_t)(b * 4 + g) * 128 * 16 * 128; }
  return it;
}
__device__ void phase2(const Params& p, lchar* shm) {
  const int tid = threadIdx.x, wid = tid >> 6, lane = tid & 63, wr = wid >> 1, wc = wid & 1, fr = lane & 15, fq = lane >> 4;
  lchar *R0 = shm, *R1 = shm + 32768, *R2 = shm + 65536, *R3 = shm + 98304;
  const bf16_t* proj = (const bf16_t*)(p.ws + OFF_PROJ);
  const bf16_t* ft = (const bf16_t*)(p.ws + OFF_FTAB);
  const bf16_t* mt = (const bf16_t*)(p.ws + OFF_MTAB);
  bf16_t* tre = (bf16_t*)((char*)p.out + OUT_H);
  bf16_t* tim = tre + (size_t)NTOK * 512;
  const float* gp = (const float*)(p.ws + OFF_GPOW);
  {
    const int g = blockIdx.x & 3, nper = gridDim.x >> 2, slot = blockIdx.x >> 2;
    if (slot < nper) {
      tile_glds(R2, mt + (size_t)(g * 2) * 16384, 128);
      tile_glds(R3, mt + (size_t)(g * 2 + 1) * 16384, 128);
      bf16x8 far[2][4], fai[2][4];
      load_afrags(far, ft); load_afrags(fai, ft + 16384);
      u32x4 xr[4];
      int j = slot;
      if (j < 384) { const FftAItem it = ffta_item(p, g, j); tile_load_regs_nt(xr, it.src, it.ld); }
      WAIT_V0(); __syncthreads();
      for (; j < 384; j += nper) {
        const FftAItem it = ffta_item(p, g, j);
        tile_store_regs(R0, xr);
        __syncthreads();
        if (j + nper < 384) { const FftAItem nx = ffta_item(p, g, j + nper); tile_load_regs_nt(xr, nx.src, nx.ld); }
        float2 twv[2];
#pragma unroll
        for (int m = 0; m < 2; ++m) twv[m] = it.tw[it.s2 * (wr * 32 + m * 16 + fr)];
        f32x4 ar[2][4], ai[2][4];
        zero_acc(ar); zero_acc(ai);
        mm128_areg<true>(ar, far, R0);
        mm128_areg<true>(ai, fai, R0);
#pragma unroll
        for (int m = 0; m < 2; ++m) {
          const float2 w = twv[m];
#pragma unroll
          for (int n = 0; n < 4; ++n)
#pragma unroll
            for (int r = 0; r < 4; ++r) { const float a = ar[m][n][r], bb = ai[m][n][r]; ar[m][n][r] = a * w.x - bb * w.y; ai[m][n][r] = a * w.y + bb * w.x; }
        }
        __syncthreads();
        acc_to_image(R0, ar); acc_to_image(R1, ai);
        __syncthreads();
        zero_acc(ar); zero_acc(ai);
        mm128<false, false>(ar, R0, R2);
        mm128<false, false>(ai, R1, R3);
#pragma unroll
        for (int m = 0; m < 2; ++m) {
          const int k1 = wr * 32 + m * 16 + fr;
          const size_t rb = it.tbase + ((size_t)k1 * it.ns2 + it.s2) * 128 + wc * 64 + fq * 8;
#pragma unroll
          for (int n2 = 0; n2 < 2; ++n2) {
            const f32x4 r0 = ar[m][2 * n2] - ai[m][2 * n2], r1 = ar[m][2 * n2 + 1] - ai[m][2 * n2 + 1];
            *(u32x4*)(tre + rb + n2 * 32) = (u32x4){pack_bf16(r0[0], r0[1]), pack_bf16(r0[2], r0[3]), pack_bf16(r1[0], r1[1]), pack_bf16(r1[2], r1[3])};
          }
        }
        zero_acc(ar);
        mm128<false, false>(ar, R0, R3);
        mm128<false, false>(ar, R1, R2);
#pragma unroll
        for (int m = 0; m < 2; ++m) {
          const int k1 = wr * 32 + m * 16 + fr;
          const size_t rb = it.tbase + ((size_t)k1 * it.ns2 + it.s2) * 128 + wc * 64 + fq * 8;
#pragma unroll
          for (int n2 = 0; n2 < 2; ++n2)
            *(u32x4*)(tim + rb + n2 * 32) = (u32x4){pack_bf16(ar[m][2 * n2][0], ar[m][2 * n2][1]), pack_bf16(ar[m][2 * n2][2], ar[m][2 * n2][3]), pack_bf16(ar[m][2 * n2 + 1][0], ar[m][2 * n2 + 1][1]), pack_bf16(ar[m][2 * n2 + 1][2], ar[m][2 * n2 + 1][3])};
        }
        __syncthreads();
      }
    }
  }
  {
    u32x4 kr[4], vr[4];
    float zfv[4], zbv[4];
    int it = blockIdx.x;
    if (it < 1536) { const bf16_t* kp = proj + (size_t)(it >> 2) * 128 * INW + 1024 + (it & 3) * 128; tile_load_regs_nt(kr, kp, INW); tile_load_regs_nt(vr, kp + 512, INW);
#pragma unroll
      for (int i = 0; i < 4; ++i) { const int row = (i * 512 + tid) >> 4; zfv[i] = gp[(it & 3) * 132 + 127 - row]; zbv[i] = gp[(4 + (it & 3)) * 132 + row]; } }
    for (; it < 1536; it += gridDim.x) {
      const int cidx = it >> 2, h = it & 3;
      tile_store_regs(R0, kr);
#pragma unroll
      for (int i = 0; i < 4; ++i) {
        const int L = i * 512 + tid, row = L >> 4, ch = L & 15;
        const float zf = zfv[i], zb = zbv[i];
        u32x4 of, ob;
#pragma unroll
        for (int e = 0; e < 4; ++e) { const float lo = bf_lo(vr[i][e]), hi = bf_hi(vr[i][e]); of[e] = pack_bf16(lo * zf, hi * zf); ob[e] = pack_bf16(lo * zb, hi * zb); }
        *(LAS u32x4*)(R1 + t_off(row, ch)) = of;
        *(LAS u32x4*)(R2 + t_off(row, ch)) = ob;
      }
      __syncthreads();
      if (it + (int)gridDim.x < 1536) { const int nx = it + gridDim.x; const bf16_t* kp = proj + (size_t)(nx >> 2) * 128 * INW + 1024 + (nx & 3) * 128; tile_load_regs_nt(kr, kp, INW); tile_load_regs_nt(vr, kp + 512, INW);
#pragma unroll
        for (int i = 0; i < 4; ++i) { const int row = (i * 512 + tid) >> 4; zfv[i] = gp[(nx & 3) * 132 + 127 - row]; zbv[i] = gp[(4 + (nx & 3)) * 132 + row]; } }
      f32x4 kf[2][4], kb[2][4];
      zero_acc(kf); zero_acc(kb);
      mm128<true, true>(kf, R0, R1);
      mm128<true, true>(kb, R0, R2);
      bf16_t* kvf = (bf16_t*)((char*)p.out + OUT_KV) + (size_t)(cidx * 4 + h) * 16384;
      bf16_t* kvb = kvf + (size_t)1536 * 16384;
#pragma unroll
      for (int m = 0; m < 2; ++m) {
        const int d = wr * 32 + m * 16 + fr;
#pragma unroll
        for (int n = 0; n < 4; ++n) {
          const int e = wc * 64 + n * 16 + fq * 4;
          *(u32x2*)(kvf + d * 128 + e) = (u32x2){pack_bf16(kf[m][n][0], kf[m][n][1]), pack_bf16(kf[m][n][2], kf[m][n][3])};
          *(u32x2*)(kvb + d * 128 + e) = (u32x2){pack_bf16(kb[m][n][0], kb[m][n][1]), pack_bf16(kb[m][n][2], kb[m][n][3])};
        }
      }
      __syncthreads();
    }
  }
}

__device__ void phase3(const Params& p, lchar* shm) {
  const int tid = threadIdx.x, wid = tid >> 6, lane = tid & 63, wr = wid >> 1, wc = wid & 1, fr = lane & 15, fq = lane >> 4;
  lchar *R0 = shm, *R1 = shm + 32768, *R2 = shm + 65536, *R3 = shm + 98304;
  bf16_t* proj = (bf16_t*)(p.ws + OFF_PROJ);
  const bf16_t* ft = (const bf16_t*)(p.ws + OFF_FTAB);
  const bf16_t* tre = (const bf16_t*)((char*)p.out + OUT_H);
  const bf16_t* tim = tre + (size_t)NTOK * 512;
  const float* gp = (const float*)(p.ws + OFF_GPOW);
  {
    const unsigned* kv = (const unsigned*)((char*)p.out + OUT_KV);
    unsigned* pv = (unsigned*)(p.ws + OFF_PREV);
    const int gtid = blockIdx.x * 512 + tid, gsz = gridDim.x * 512;
#if DBG == 17
    for (int rep = 0; rep < 2; ++rep)
#endif
    for (int w = gtid; w < 16 * 8192 + 64 * 8192; w += gsz) {
      int dir, h, c0, nch;
      const int pr = w & 8191;
      if (w < 16 * 8192) { const int ch = w >> 13; dir = ch >> 3; const int b = (ch >> 2) & 1; h = ch & 3; c0 = b * 128; nch = 128; }
      else { const int ch = (w >> 13) - 16; dir = ch >> 5; const int b = (ch >> 2) & 7; h = ch & 3; c0 = 256 + b * 16; nch = 16; }
      const float g = gp[(dir * 4 + h) * 132 + 128];
      const size_t boff = (size_t)dir * 1536 * 8192 + (size_t)h * 8192 + pr;
      const unsigned* base = kv + boff; unsigned* obase = pv + boff;
      float s0 = 0.f, s1 = 0.f;
      for (int n8 = 0; n8 < nch; n8 += 16) {
        unsigned t[16];
#pragma unroll
        for (int j = 0; j < 16; ++j) { const int n = dir ? (nch - 1 - (n8 + j)) : (n8 + j); t[j] = __builtin_nontemporal_load(base + (size_t)(c0 + n) * 4 * 8192); }
#pragma unroll
        for (int j = 0; j < 16; ++j) {
          const int n = dir ? (nch - 1 - (n8 + j)) : (n8 + j);
          obase[(size_t)(c0 + n) * 4 * 8192] = pack_bf16(s0, s1);
          s0 = s0 * g + bf_lo(t[j]); s1 = s1 * g + bf_hi(t[j]);
        }
      }
    }
  }
  {
    auto tb_of = [&](int item) -> size_t {
      if (item < 1024) { const int b = item >> 9, g = (item >> 7) & 3, k1 = item & 127; return ((size_t)(b * 4 + g) * 128 + k1) * 16384; }
      const int j = item - 1024, b = j >> 6, g = (j >> 4) & 3, kg = j & 15; return (size_t)16777216 + ((size_t)(b * 4 + g) * 128 + kg * 8) * 2048;
    };
    bf16x8 fa[2][4], fs[2][4];
    u32x4 tr[4], ti[4];
    int cur_tabs = -1;
    int item = blockIdx.x;
    if (item < 1536) { const size_t tb = tb_of(item); tile_load_regs_nt(tr, tre + tb, 128); tile_load_regs_nt(ti, tim + tb, 128); }
    for (; item < 1536; item += gridDim.x) {
      const int tabs = item < 1024 ? 0 : 1;
      if (tabs != cur_tabs) { load_afrags(fa, ft + (tabs ? 3 * 16384 : 0)); load_afrags(fs, ft + (tabs ? 4 * 16384 : 2 * 16384)); cur_tabs = tabs; }
      tile_store_regs(R0, tr); tile_store_regs(R1, ti);
      __syncthreads();
      if (item + (int)gridDim.x < 1536) { const size_t tb = tb_of(item + gridDim.x); tile_load_regs_nt(tr, tre + tb, 128); tile_load_regs_nt(ti, tim + tb, 128); }
      f32x4 y[2][4];
      zero_acc(y);
      mm128_areg<true>(y, fa, R0);
      mm128_areg<true>(y, fs, R1);
      int b, g, k1;
      if (item < 1024) { b = item >> 9; g = (item >> 7) & 3; k1 = item & 127; }
      else { const int j = item - 1024; b = j >> 6; g = (j >> 4) & 3; k1 = j & 15; }
#pragma unroll
      for (int m = 0; m < 2; ++m) {
        const int o = wr * 32 + m * 16 + fr;
        const int R = tabs ? (PROWS + b * 2048 + (k1 * 8 + (o >> 4)) + 128 * (o & 15)) : (b * 16384 + k1 + 128 * o);
        bf16_t* rowp = proj + (size_t)R * INW + g * 128 + wc * 64 + fq * 8;
#pragma unroll
        for (int n2 = 0; n2 < 2; ++n2)
          *(u32x4*)(rowp + n2 * 32) = (u32x4){pack_bf16(y[m][2 * n2][0], y[m][2 * n2][1]), pack_bf16(y[m][2 * n2][2], y[m][2 * n2][3]), pack_bf16(y[m][2 * n2 + 1][0], y[m][2 * n2 + 1][1]), pack_bf16(y[m][2 * n2 + 1][2], y[m][2 * n2 + 1][3])};
      }
      __syncthreads();
    }
  }
}

__device__ void phase4(const Params& p, lchar* shm, bool dummy = false) {
  const int tid = threadIdx.x, wid = tid >> 6, lane = tid & 63, wr = wid >> 1, wc = wid & 1, fr = lane & 15, fq = lane >> 4;
  lchar *R0 = shm, *R1 = shm + 32768, *R2 = shm + 65536, *R3 = shm + 98304;
  LAS float* xt = (LAS float*)(shm + 131072);
  LAS float* red = xt + 264;
  bf16_t* proj = (bf16_t*)(p.ws + OFF_PROJ);
  const float* gp = (const float*)(p.ws + OFF_GPOW);
  const bf16_t* kvall = (const bf16_t*)(p.ws + OFF_PREV);
  for (int item = blockIdx.x; item < 1536; item += gridDim.x) {
    const int cidx = item >> 2, h = item & 3;
    bf16_t* base = proj + (size_t)cidx * 128 * INW + h * 128;
    tile_glds(R0, base + 512, INW);
    tile_glds(R1, base + 1024, INW);
    tile_glds(R2, base + 1536, INW);
    tile_glds(R3, kvall + (size_t)(cidx * 4 + h) * 16384, 128);
    if (tid < 264) xt[tid] = gp[(tid < 132 ? h : 4 + h) * 132 + (tid < 132 ? tid : tid - 132)];
    WAIT_V0(); __syncthreads();
    f32x4 s[2][4], o[2][4];
    zero_acc(s); zero_acc(o);
    mm128<false, false>(s, R0, R1);
    mm128<false, true>(o, R0, R3);
    __syncthreads();
    tile_glds(R3, kvall + (size_t)(1536 + cidx * 4 + h) * 16384, 128);
#pragma unroll
    for (int m = 0; m < 2; ++m) {
      const int i = wr * 32 + m * 16 + fr;
      const float ratio = xt[i + 1] / xt[132 + 128 - i];
#pragma unroll
      for (int n = 0; n < 4; ++n)
#pragma unroll
        for (int r = 0; r < 4; ++r) {
          const int j = wc * 64 + n * 16 + fq * 4 + r, dd = i - j;
          s[m][n][r] *= (dd >= 0) ? xt[dd] : xt[132 - dd];
          o[m][n][r] *= ratio;
        }
    }
    acc_to_image(R1, s);
    u32x4 gw[4];
#pragma unroll
    for (int i = 0; i < 4; ++i) { const int L = i * 512 + tid; gw[i] = __builtin_nontemporal_load((const u32x4*)(base + (size_t)(L >> 4) * INW + 2048 + (L & 15) * 8)); }
    WAIT_V0(); __syncthreads();
    mm128<false, true>(o, R0, R3);
#pragma unroll
    for (int m = 0; m < 2; ++m) {
      const float xb = xt[132 + 128 - (wr * 32 + m * 16 + fr)];
#pragma unroll
      for (int n = 0; n < 4; ++n) o[m][n] *= xb;
    }
    mm128<false, true>(o, R1, R2);
    float ss[2];
#pragma unroll
    for (int m = 0; m < 2; ++m) {
      float a = 0.f;
#pragma unroll
      for (int n = 0; n < 4; ++n) a += o[m][n][0] * o[m][n][0] + o[m][n][1] * o[m][n][1] + o[m][n][2] * o[m][n][2] + o[m][n][3] * o[m][n][3];
      a += __shfl_xor(a, 16); a += __shfl_xor(a, 32);
      ss[m] = a;
      if (fq == 0) red[wc * 128 + wr * 32 + m * 16 + fr] = a;
    }
    __syncthreads();
#pragma unroll
    for (int m = 0; m < 2; ++m) {
      const int i = wr * 32 + m * 16 + fr;
      const float tot = red[i] + red[128 + i];
      const float rinv = rsqrtf(tot * (1.f / 128.f) + 1e-6f);
#pragma unroll
      for (int n = 0; n < 4; ++n) o[m][n] *= rinv;
    }
    (void)ss;
    acc_to_image(R0, o);
    __syncthreads();
#pragma unroll
    for (int i = 0; i < 4; ++i) {
      const int L = i * 512 + tid, row = L >> 4, ch = L & 15;
      const u32x4 rv = *(const LAS u32x4*)(R0 + t_off(row, ch));
      u32x4 ov;
#pragma unroll
      for (int e = 0; e < 4; ++e) ov[e] = pack_bf16(bf_lo(rv[e]) * bf_lo(gw[i][e]), bf_hi(rv[e]) * bf_hi(gw[i][e]));
      *(u32x4*)(base + (size_t)row * INW + 2048 + ch * 8) = ov;
    }
    __syncthreads();
  }
}

#define XB_TMO      128
#define XB_XCNT(j)  (256  + 64 * (j))
#define XB_XSUB(j)  (1280 + 64 * (j))
#define XB_XGEN(j)  (2304 + 64 * (j))
#define XB_TOP      3328
#define XB_TOPGEN   3392
#define XCD_BAR_WORDS 3456
#define XB_SPIN_CAP (1u << 18)
__device__ __forceinline__ unsigned xb_ld(unsigned* p)              { return __hip_atomic_load(p, __ATOMIC_RELAXED, __HIP_MEMORY_SCOPE_AGENT); }
__device__ __forceinline__ unsigned xb_add(unsigned* p, unsigned v) { return __hip_atomic_fetch_add(p, v, __ATOMIC_RELAXED, __HIP_MEMORY_SCOPE_AGENT); }
__device__ __forceinline__ unsigned xb_xcc_id() { return (unsigned)__builtin_amdgcn_s_getreg((3 << 11) | 20) & 0xFu; }
#define XB_SPIN(cond, bar) do { unsigned _sp = 0; while (cond) { __builtin_amdgcn_s_sleep(1); \
    if ((++_sp & 255u) == 0u) { if (xb_ld(&(bar)[XB_TMO])) break; if (_sp > XB_SPIN_CAP) { atomicAdd(&(bar)[XB_TMO], 1u); break; } } } } while (0)
struct XcdBarrier { unsigned* bar; unsigned x; volatile LAS unsigned* st; };
__device__ __forceinline__ XcdBarrier xcd_barrier_post(unsigned* bar, volatile LAS unsigned* st) {
  XcdBarrier b; b.bar = bar; b.x = xb_xcc_id(); b.st = st;
  if (threadIdx.x == 0) (void)xb_add(&bar[XB_XCNT(b.x)], 1u);
  return b;
}
__device__ __forceinline__ void xcd_barrier_complete(unsigned* bar, unsigned x, unsigned& nloc, unsigned& nx) {
  const unsigned G = gridDim.x * gridDim.y * gridDim.z;
  unsigned sum, cnt, mine, sp = 0u;
  for (;;) {
    sum = 0u; cnt = 0u; mine = 0u;
#pragma unroll
    for (unsigned j = 0; j < 16; ++j) { const unsigned c = xb_ld(&bar[XB_XCNT(j)]); sum += c; cnt += (c > 0u) ? 1u : 0u; mine = (j == x) ? c : mine; }
    if (sum == G) break;
    __builtin_amdgcn_s_sleep(1);
    if ((++sp & 255u) == 0u) { if (xb_ld(&bar[XB_TMO])) break; if (sp > XB_SPIN_CAP) { atomicAdd(&bar[XB_TMO], 1u); break; } }
  }
  nloc = mine > 0u ? mine : 1u; nx = cnt > 0u ? cnt : 1u;
}
__device__ __forceinline__ void xcd_barrier(const XcdBarrier& b) {
  asm volatile("s_waitcnt vmcnt(0)" ::: "memory");
  __syncthreads();
  if (threadIdx.x == 0) {
    unsigned* bar = b.bar;
    __builtin_amdgcn_s_waitcnt(0);
    unsigned nloc = b.st[0], nx = b.st[1];
    if (nloc == 0u) { xcd_barrier_complete(bar, b.x, nloc, nx); b.st[0] = nloc; b.st[1] = nx; }
    const unsigned old = xb_add(&bar[XB_XSUB(b.x)], 1u);
    const unsigned gen = old / nloc;
    if (old + 1u == (gen + 1u) * nloc) {
      __builtin_amdgcn_fence(__ATOMIC_RELEASE, "agent");
      asm volatile("s_waitcnt vmcnt(0)" ::: "memory");
      const unsigned og = xb_add(&bar[XB_TOP], 1u);
      const unsigned tg = og / nx;
      if (og + 1u == (tg + 1u) * nx) xb_add(&bar[XB_TOPGEN], 1u);
      else XB_SPIN(xb_ld(&bar[XB_TOPGEN]) == tg, bar);
      __builtin_amdgcn_fence(__ATOMIC_ACQUIRE, "agent");
      xb_add(&bar[XB_XGEN(b.x)], 1u);
      asm volatile("s_waitcnt vmcnt(0)" ::: "memory");
    } else {
      XB_SPIN(xb_ld(&bar[XB_XGEN(b.x)]) == gen, bar);
      __builtin_amdgcn_fence(__ATOMIC_ACQUIRE, "agent");
      asm volatile("s_waitcnt vmcnt(0)" ::: "memory");
    }
  }
  __syncthreads();
}

template <bool COOP>
__global__ void __launch_bounds__(512) mk_forward(Params p, int ph0, int ph1) {
  __shared__ __attribute__((aligned(1024))) char shm_[LDS_BYTES];
  lchar* shm = (lchar*)shm_;
#ifdef ONLY_PHASE
#define PH_ON(k) ((k) == ONLY_PHASE)
#else
#define PH_ON(k) (ph0 <= (k) && (k) <= ph1)
#endif
  XcdBarrier xb{};
  if (COOP) {
    volatile LAS unsigned* st = (volatile LAS unsigned*)(shm + 131072 + 3584);
    if (threadIdx.x == 0) { st[0] = 0u; st[1] = 0u; st[2] = 0u; st[3] = 0u; }
    __syncthreads();
    xb = xcd_barrier_post((unsigned*)(p.ws + OFF_BAR), st);
    if (ph1 > 1000) cg::this_grid().sync();
  }
#define PH_SYNC(k) do { if (COOP && ph0 <= (k) && (k) < ph1) xcd_barrier(xb); } while (0)
  if (PH_ON(0)) phase0a(p, shm);
#if DBG == 13
  __syncthreads();
  if (PH_ON(0)) phase0a(p, shm);
#endif
  PH_SYNC(0);
  if (PH_ON(1)) rows_phase(p, 0);
#if DBG == 14
  if (PH_ON(1)) rows_phase(p, 0);
#endif
  PH_SYNC(1);
  if (PH_ON(2)) gemm_phase8(shm, (const bf16_t*)((const char*)p.out + OUT_H), DM, 1 << 30, 0, (const bf16_t*)(p.ws + OFF_WIN), DM, INW, Epi8InProj{p});
  if (PH_ON(2)) { __syncthreads(); bias2_items(p, shm); late_transposes(p, shm); }
#if DBG == 11
  __syncthreads();
  if (PH_ON(2)) gemm_phase8(shm, (const bf16_t*)((const char*)p.out + OUT_H), DM, 1 << 30, 0, (const bf16_t*)(p.ws + OFF_WIN), DM, INW, Epi8InProj{p});
#endif
  PH_SYNC(2);
  if (PH_ON(3)) phase2(p, shm);
#if DBG == 12
  __syncthreads();
  if (PH_ON(3)) phase2(p, shm);
#endif
  PH_SYNC(3);
  if (PH_ON(4)) phase3(p, shm);
  PH_SYNC(4);
#if DBG == 16
  if (PH_ON(5)) phase4(p, shm, true);
  __syncthreads();
#endif
  if (PH_ON(5)) phase4(p, shm);
  PH_SYNC(5);
  if (PH_ON(6)) gemm_phase8(shm, (const bf16_t*)(p.ws + OFF_PROJ), INW, 512, 1536, (const bf16_t*)(p.ws + OFF_WOUT), DM, DM, Epi8OutProj{p});
  PH_SYNC(6);
  if (PH_ON(8)) gemm_phase8(shm, (const bf16_t*)(p.ws + OFF_H2), DM, 1 << 30, 0, (const bf16_t*)(p.ws + OFF_W1), DM, DFF, Epi8MlpIn{p});
#if DBG == 10
  __syncthreads();
  if (PH_ON(8)) gemm_phase8(shm, (const bf16_t*)(p.ws + OFF_H2), DM, 1 << 30, 0, (const bf16_t*)(p.ws + OFF_W1), DM, DFF, Epi8MlpIn{p});
#endif
  PH_SYNC(8);
  if (PH_ON(9)) gemm_phase8(shm, (const bf16_t*)(p.ws + OFF_PROJ), DFF, 1 << 30, 0, (const bf16_t*)(p.ws + OFF_W2), DFF, DM, Epi8MlpOut{p});
  PH_SYNC(9);
  if (PH_ON(10)) rows_phase(p, 2);
}

extern "C" void kernel_launch(void* const* d_in, const int* in_sizes, int n_in, void* d_out, int out_size, void* d_ws, size_t ws_size,
                              hipStream_t stream) {
  Params p{};
  p.x_prompt = (const float*)d_in[0]; p.x_sample = (const float*)d_in[1]; p.c_prompt = (const float*)d_in[2]; p.c_sample = (const float*)d_in[3];
  p.ada_w = (const float*)d_in[4]; p.ada_b = (const float*)d_in[5]; p.norm_mix = (const float*)d_in[6]; p.w_in = (const float*)d_in[7];
  p.w_fnet = (const float*)d_in[8]; p.w_out = (const float*)d_in[9]; p.norm_mlp = (const float*)d_in[10]; p.w_mlp_in = (const float*)d_in[11];
  p.w_mlp_out = (const float*)d_in[12]; p.norm_final = (const float*)d_in[13];
  p.out = (float*)d_out; p.ws = (char*)d_ws;
  if (ws_size < WS_END) { fprintf(stderr, "workspace too small: %zu < %zu\n", ws_size, (size_t)WS_END); return; }
#if MK_COOP
  static int grid_blocks = 0;
  if (!grid_blocks) {
    int dev = 0, cus = 0, per_cu = 0;
    hipGetDevice(&dev);
    hipDeviceGetAttribute(&cus, hipDeviceAttributeMultiprocessorCount, dev);
    hipOccupancyMaxActiveBlocksPerMultiprocessor(&per_cu, mk_forward<true>, 512, 0);
    if (per_cu > 1) per_cu = 1;
    grid_blocks = cus * per_cu;
  }
  hipMemsetAsync((char*)d_ws + OFF_BAR, 0, 3456 * 4, stream);
  int ph0 = 0, ph1 = 10;
  void* args[] = {&p, &ph0, &ph1};
  hipError_t e = hipLaunchCooperativeKernel((void*)mk_forward<true>, dim3(grid_blocks), dim3(512), args, 0, stream);
  if (e != hipSuccess) fprintf(stderr, "cooperative launch failed: %s (grid %d)\n", hipGetErrorString(e), grid_blocks);
#else
  for (int ph = 0; ph <= 10; ++ph) mk_forward<false><<<256, 512, 0, stream>>>(p, ph, ph);
#endif
}
```

```cpp
#include <hip/hip_runtime.h>
#include <hip/hip_cooperative_groups.h>
#include <cstdio>
namespace cg = cooperative_groups;

#ifndef DBG
#define DBG 0
#endif
#ifndef MK_COOP
#define MK_COOP 1
#endif

#define LAS __attribute__((address_space(3)))
typedef LAS char lchar;
typedef unsigned short bf16_t;
typedef short bf16x8 __attribute__((ext_vector_type(8)));
typedef short s16x4 __attribute__((ext_vector_type(4)));
typedef float f32x4 __attribute__((ext_vector_type(4)));
typedef unsigned u32x2 __attribute__((ext_vector_type(2)));
typedef float f32x2 __attribute__((ext_vector_type(2)));
typedef unsigned u32x4 __attribute__((ext_vector_type(4)));

constexpr int NTOK = 49152, DM = 1024, INW = 2560, DFF = 4096;
constexpr int PROWS = 32768;
constexpr int NB = 10;
constexpr int LDS_BYTES = 4 * 32768 + 4096;

constexpr size_t OFF_PROJ = 0;
constexpr size_t OFF_PREV = (size_t)NTOK * INW * 2;
constexpr size_t OFF_H2   = (size_t)NTOK * DFF * 2;
constexpr size_t OFF_WIN  = OFF_H2 + (size_t)NTOK * DM * 2;
constexpr size_t OFF_WOUT = OFF_WIN + (size_t)INW * DM * 2;
constexpr size_t OFF_W1   = OFF_WOUT + (size_t)DM * DM * 2;
constexpr size_t OFF_W2   = OFF_W1 + (size_t)DFF * DM * 2;
constexpr size_t OFF_MOD  = OFF_W2 + (size_t)DFF * DM * 2;
constexpr size_t OFF_ROT  = OFF_MOD + (size_t)NB * 6144 * 4;
constexpr size_t OFF_FTAB = OFF_ROT + 2 * 128 * 64 * 8;
constexpr size_t OFF_MTAB = OFF_FTAB + 5 * 32768;
constexpr size_t OFF_TWP  = OFF_MTAB + 8 * 32768;
constexpr size_t OFF_TWS  = OFF_TWP + 16384 * 8;
constexpr size_t OFF_GPOW = OFF_TWS + 2048 * 8;
constexpr size_t OFF_BAR  = (OFF_GPOW + 2 * 4 * 132 * 4 + 255) / 256 * 256;
constexpr size_t OFF_SSQ  = OFF_BAR + 3456 * 4;
constexpr size_t OFF_BIAS2 = OFF_SSQ + (size_t)NTOK * 16 * 4;
constexpr size_t WS_END   = OFF_BIAS2 + (size_t)NB * DFF * 4;
static_assert(WS_END <= (size_t)536870912, "workspace");
constexpr size_t OUT_H   = 0;
constexpr size_t OUT_KV  = (size_t)NTOK * DM * 2;

struct Params {
  const float *x_prompt, *x_sample, *c_prompt, *c_sample, *ada_w, *ada_b, *norm_mix, *w_in, *w_fnet, *w_out,
      *norm_mlp, *w_mlp_in, *w_mlp_out, *norm_final;
  float* out;
  char* ws;
};

__device__ __forceinline__ unsigned pack_bf16(float lo, float hi) {
  unsigned r; asm("v_cvt_pk_bf16_f32 %0, %1, %2" : "=v"(r) : "v"(lo), "v"(hi)); return r;
}
__device__ __forceinline__ float bf_lo(unsigned u) { return __uint_as_float(u << 16); }
__device__ __forceinline__ float bf_hi(unsigned u) { return __uint_as_float(u & 0xffff0000u); }
__device__ __forceinline__ int row_batch(int R) { return R < PROWS ? (R >> 14) : 2 + ((R - PROWS) >> 11); }
__device__ __forceinline__ int row_pos(int R) { return R < PROWS ? (R & 16383) : ((R - PROWS) & 2047); }
__device__ __forceinline__ const float* xrow(const Params& p, int R) {
  return R < PROWS ? p.x_prompt + (size_t)R * DM : p.x_sample + (size_t)(R - PROWS) * DM;
}
__device__ __forceinline__ float silu_f(float v) { return v / (1.f + __expf(-v)); }
#define WAIT_V0() asm volatile("s_waitcnt vmcnt(0)" ::: "memory")

__device__ void sincos_d(double x, double& s, double& c) {
  double q = rint(x * 0.63661977236758134308);
  double r = fma(-q, 1.57079632679489655800e+00, x);
  r = fma(-q, 6.12323399573676603587e-17, r);
  int qi = (int)(((long long)q) & 3);
  double r2 = r * r;
  double sp = r * (1.0 + r2 * (-1.0 / 6 + r2 * (1.0 / 120 + r2 * (-1.0 / 5040 + r2 * (1.0 / 362880 + r2 * (-1.0 / 39916800 + r2 * (1.0 / 6227020800.0)))))));
  double cp = 1.0 + r2 * (-0.5 + r2 * (1.0 / 24 + r2 * (-1.0 / 720 + r2 * (1.0 / 40320 + r2 * (-1.0 / 3628800 + r2 * (1.0 / 479001600.0 + r2 * (-1.0 / 87178291200.0)))))));
  if (qi == 0) { s = sp; c = cp; } else if (qi == 1) { s = cp; c = -sp; } else if (qi == 2) { s = -sp; c = -cp; } else { s = -cp; c = sp; }
}

__device__ __forceinline__ int lds_byte2(int r, int c) {
  int st = (r >> 4) * 2 + (c >> 5), ob = (r & 15) * 64 + (c & 31) * 2;
  return st * 1024 + (ob ^ (((ob >> 9) & 1) << 5));
}
__device__ __forceinline__ void stage_rc2(int b, int& R, int& C) {
  int st = b >> 10, sb = b & 1023, swz = sb ^ (((sb >> 9) & 1) << 5);
  R = (st >> 1) * 16 + swz / 64;
  C = (st & 1) * 32 + (swz % 64) / 2;
}
__device__ __forceinline__ void unit_map(int u, int nM, int nN, int& pm, int& pn, int wgm = 8) {
  int nwg = nM * nN, wgid = u;
  { int q = nwg / 8, r = nwg % 8, xcd = wgid % 8, off = wgid / 8; wgid = (xcd < r ? xcd * (q + 1) : r * (q + 1) + (xcd - r) * q) + off; }
  int nig = wgm * nN, gid = wgid / nig, fm = gid * wgm, gsz = min(nM - fm, wgm);
  pm = fm + ((wgid % nig) % gsz); pn = (wgid % nig) / gsz;
}

template <class Epi>
__device__ __forceinline__ void gemm_unit(lchar* shm, const bf16_t* __restrict__ A, int lda, int ksplit, int kjump,
                                          const bf16_t* __restrict__ Bt, int K, int pm, int pn, const Epi& epi) {
  constexpr int TILE_B = 256 * 64 * 2, STAGE_B = 2 * TILE_B;
  const int tid = threadIdx.x, wid = tid >> 6, lane = tid & 63, wr = wid >> 2, wc = wid & 3, fr = lane & 15, fq = lane >> 4;
  const bf16_t* Ab = A + (size_t)pm * 256 * lda;
  const bf16_t* Bb = Bt + (size_t)pn * 256 * K;
  int offA[4], offB[4];
#pragma unroll
  for (int i = 0; i < 4; ++i) { int r, c; stage_rc2(wid * 1024 + i * 8192 + lane * 16, r, c); offA[i] = r * lda + c; offB[i] = r * K + c; }
  f32x4 acc[8][4];
#pragma unroll
  for (int m = 0; m < 8; ++m)
#pragma unroll
    for (int n = 0; n < 4; ++n) acc[m][n] = (f32x4){0.f, 0.f, 0.f, 0.f};
  const int nt = K / 64;
#define G_STAGE(buf, kt) do { const int kc_ = (kt) * 64; const int ka_ = kc_ + (kc_ >= ksplit ? kjump : 0);            \
    _Pragma("unroll") for (int i = 0; i < 4; ++i) {                                                                    \
      __builtin_amdgcn_global_load_lds((const unsigned*)(Ab + offA[i] + ka_), (LAS unsigned*)(shm + (buf) * STAGE_B + wid * 1024 + i * 8192), 16, 0, 0); \
      __builtin_amdgcn_global_load_lds((const unsigned*)(Bb + offB[i] + kc_), (LAS unsigned*)(shm + (buf) * STAGE_B + TILE_B + wid * 1024 + i * 8192), 16, 0, 0); } } while (0)
  G_STAGE(0, 0); WAIT_V0(); __syncthreads();
  for (int t = 0; t < nt; ++t) {
    const int cur = t & 1;
    if (t + 1 < nt) G_STAGE(cur ^ 1, t + 1);
#pragma unroll
    for (int ks = 0; ks < 2; ++ks) {
      bf16x8 At[8], Bf[4];
#pragma unroll
      for (int m = 0; m < 8; ++m) At[m] = *(const LAS bf16x8*)(shm + cur * STAGE_B + lds_byte2(wr * 128 + m * 16 + fr, ks * 32 + fq * 8));
#pragma unroll
      for (int n = 0; n < 4; ++n) Bf[n] = *(const LAS bf16x8*)(shm + cur * STAGE_B + TILE_B + lds_byte2(wc * 64 + n * 16 + fr, ks * 32 + fq * 8));
#pragma unroll
      for (int m = 0; m < 8; ++m)
#pragma unroll
        for (int n = 0; n < 4; ++n) acc[m][n] = __builtin_amdgcn_mfma_f32_16x16x32_bf16(Bf[n], At[m], acc[m][n], 0, 0, 0);
      __builtin_amdgcn_sched_barrier(0);
    }
    WAIT_V0(); __syncthreads();
  }
#undef G_STAGE
  epi(acc, pm * 256 + wr * 128 + fr, pn, wc, fq);
}

struct EpiInProj {
  const Params& p;
  __device__ __forceinline__ void operator()(f32x4 (&acc)[8][4], int row0, int pn, int wc, int fq) const {
    bf16_t* proj = (bf16_t*)(p.ws + OFF_PROJ);
    const float2* rotA = (const float2*)(p.ws + OFF_ROT);
    const float2* rotB = rotA + 128 * 64;
    const int kind = pn >> 1;
    const int cbase = pn * 256 + (wc >> 1) * 128 + (wc & 1) * 32 + fq * 4;
#pragma unroll
    for (int m = 0; m < 8; ++m) {
      const int R = row0 + 16 * m;
      bf16_t* rowp = proj + (size_t)R * INW + cbase;
      if (kind == 1 || kind == 2) {
        const int pos = row_pos(R);
        const float sc = (kind == 2) ? 0.08838834764831845f : 1.f;
#pragma unroll
        for (int n = 0; n < 2; ++n) {
          const int j = (wc & 1) * 32 + n * 16 + fq * 4;
          f32x4 o1, o2;
#pragma unroll
          for (int r = 0; r < 4; ++r) {
            const float2 a = rotA[(pos >> 7) * 64 + j + r], b = rotB[(pos & 127) * 64 + j + r];
            const float c = a.x * b.x - a.y * b.y, s = a.y * b.x + a.x * b.y;
            const float x1 = acc[m][n][r], x2 = acc[m][n + 2][r];
            o1[r] = (x1 * c - x2 * s) * sc; o2[r] = (x1 * s + x2 * c) * sc;
          }
          *(u32x2*)(rowp + n * 16) = (u32x2){pack_bf16(o1[0], o1[1]), pack_bf16(o1[2], o1[3])};
          *(u32x2*)(rowp + 64 + n * 16) = (u32x2){pack_bf16(o2[0], o2[1]), pack_bf16(o2[2], o2[3])};
        }
      } else {
#pragma unroll
        for (int n = 0; n < 4; ++n) {
          f32x4 v = acc[m][n];
          if (kind == 4) { v[0] = silu_f(v[0]); v[1] = silu_f(v[1]); v[2] = silu_f(v[2]); v[3] = silu_f(v[3]); }
          *(u32x2*)(rowp + (n >> 1) * 64 + (n & 1) * 16) = (u32x2){pack_bf16(v[0], v[1]), pack_bf16(v[2], v[3])};
        }
      }
    }
  }
};
struct EpiOutProj {
  const Params& p;
  __device__ __forceinline__ void operator()(f32x4 (&acc)[8][4], int row0, int pn, int wc, int fq) const {
    const float* mod = (const float*)(p.ws + OFF_MOD);
    const int c0 = pn * 256 + wc * 64 + fq * 4;
    const float* gt = mod + row_batch(row0) * 6144 + 2048 + c0;
    f32x4 g[4];
#pragma unroll
    for (int n = 0; n < 4; ++n) g[n] = *(const f32x4*)(gt + n * 16);
#pragma unroll
    for (int m = 0; m < 8; ++m) {
      const int R = row0 + 16 * m;
      const float* xr = xrow(p, R) + c0;
      float* orow = p.out + (size_t)R * DM + c0;
#pragma unroll
      for (int n = 0; n < 4; ++n) { f32x4 xv = *(const f32x4*)(xr + n * 16); *(f32x4*)(orow + n * 16) = xv + g[n] * acc[m][n]; }
    }
  }
};
struct EpiMlpIn {
  const Params& p;
  __device__ __forceinline__ void operator()(f32x4 (&acc)[8][4], int row0, int pn, int wc, int fq) const {
    bf16_t* hid = (bf16_t*)(p.ws + OFF_PROJ);
    const int c0 = pn * 256 + wc * 64 + fq * 4;
#pragma unroll
    for (int m = 0; m < 8; ++m) {
      bf16_t* rowp = hid + (size_t)(row0 + 16 * m) * DFF + c0;
#pragma unroll
      for (int n = 0; n < 4; ++n) {
        f32x4 v = acc[m][n];
#pragma unroll
        for (int r = 0; r < 4; ++r) { float t = fmaxf(v[r], 0.f); v[r] = t * t; }
        *(u32x2*)(rowp + n * 16) = (u32x2){pack_bf16(v[0], v[1]), pack_bf16(v[2], v[3])};
      }
    }
  }
};
struct EpiMlpOut {
  const Params& p;
  __device__ __forceinline__ void operator()(f32x4 (&acc)[8][4], int row0, int pn, int wc, int fq) const {
    const float* mod = (const float*)(p.ws + OFF_MOD);
    const int c0 = pn * 256 + wc * 64 + fq * 4;
    const float* gt = mod + row_batch(row0) * 6144 + 5120 + c0;
    f32x4 g[4];
#pragma unroll
    for (int n = 0; n < 4; ++n) g[n] = *(const f32x4*)(gt + n * 16);
#pragma unroll
    for (int m = 0; m < 8; ++m) {
      float* orow = p.out + (size_t)(row0 + 16 * m) * DM + c0;
#pragma unroll
      for (int n = 0; n < 4; ++n) { f32x4 xv = *(const f32x4*)(orow + n * 16);
#if DBG == 3
        *(f32x4*)(orow + n * 16) = xv;
#else
        *(f32x4*)(orow + n * 16) = xv + g[n] * acc[m][n];
#endif
      }
    }
  }
};

template <class Epi>
__device__ __forceinline__ void gemm_phase(lchar* shm, const bf16_t* A, int lda, int ksplit, int kjump, const bf16_t* Bt, int K, int N, const Epi& epi) {
  const int nM = NTOK / 256, nN = N / 256;
  for (int u = blockIdx.x; u < nM * nN; u += gridDim.x) { int pm, pn; unit_map(u, nM, nN, pm, pn); gemm_unit(shm, A, lda, ksplit, kjump, Bt, K, pm, pn, epi); }
}


__device__ __forceinline__ int perm32(int rho) { const int n = rho >> 4, i = rho & 15; return 8 * (i >> 2) + 4 * n + (i & 3); }
__device__ __forceinline__ int invperm32(int w) { return 16 * ((w >> 2) & 1) + 4 * (w >> 3) + (w & 3); }
template <int WGM = 8, class Epi>
__device__ __forceinline__ void gemm_phase8(lchar* lds, const bf16_t* A, int lda, int ksplit, int kjump, const bf16_t* Bt, int K, int N, const Epi& E) {
  constexpr int HTB = 128 * 64 * 2;
  const int tid = threadIdx.x, wid = __builtin_amdgcn_readfirstlane(tid >> 6), lane = tid & 63, wr = wid >> 2, wc = wid & 3, fr = lane & 15, fq = lane >> 4;
  const int nt = K / 64, nM = NTOK / 256, nN = N / 256, nU = nM * nN, G = gridDim.x;
  unsigned voffA[2], voffB[2];
#pragma unroll
  for (int i = 0; i < 2; ++i) { int R, C; stage_rc2(tid * 16 + i * 8192, R, C); voffA[i] = (unsigned)(R * lda + C) * 2u; voffB[i] = (unsigned)(R * K + C) * 2u; }
  const size_t kstep = 128, hstepA = (size_t)128 * lda * 2, hstepB = (size_t)128 * K * 2, tstepA = 2 * hstepA, tstepB = 2 * hstepB;
  const unsigned ldsw = (unsigned)wid * 1024u;
  const int aoff = lds_byte2(wr * 64 + fr, fq * 8), boff = lds_byte2(wc * 32 + fr, fq * 8);
#define ACOLB(t) ((size_t)(((t) * 64 + (((t) * 64 >= ksplit) ? kjump : 0)) * 2))
#define P8_SA(b, h) (((b) * 2 + (h)) * HTB)
#define P8_SB(b, h) ((4 + (b) * 2 + (h)) * HTB)
#define P8_STAGE(bufoff, gbase, voff) do { _Pragma("unroll") for (int _i = 0; _i < 2; ++_i) \
    __builtin_amdgcn_global_load_lds((const unsigned*)((const char*)(gbase) + (voff)[_i]), (LAS unsigned*)(lds + (bufoff) + ldsw + _i * 8192), 16, 0, 0); } while (0)
#define P8_LDA(dst, b, h) do { _Pragma("unroll") for (int m = 0; m < 4; ++m) _Pragma("unroll") for (int k = 0; k < 2; ++k) dst[m][k] = *(const LAS bf16x8*)(lds + P8_SA(b, h) + aoff + m * 2048 + k * 1024); } while (0)
#define P8_LDB(dst, b, h) do { _Pragma("unroll") for (int n = 0; n < 2; ++n) _Pragma("unroll") for (int k = 0; k < 2; ++k) dst[n][k] = *(const LAS bf16x8*)(lds + P8_SB(b, h) + boff + n * 2048 + k * 1024); } while (0)
#define P8_MMA(ai, bj, At_, Bt_) do { __builtin_amdgcn_s_setprio(1); _Pragma("unroll") for (int m = 0; m < 4; ++m) _Pragma("unroll") for (int n = 0; n < 2; ++n) _Pragma("unroll") for (int k = 0; k < 2; ++k) \
    acc[ai][bj][m][n] = __builtin_amdgcn_mfma_f32_16x16x32_bf16(Bt_[n][k], At_[m][k], acc[ai][bj][m][n], 0, 0, 0); __builtin_amdgcn_s_setprio(0); } while (0)
#define P8_WAIT_V(n) asm volatile("s_waitcnt vmcnt(" #n ")" ::: "memory")
#define P8_WAIT_L(n) asm volatile("s_waitcnt lgkmcnt(" #n ")" ::: "memory")
#define P8_BAR __builtin_amdgcn_s_barrier()
#define P8_SCHED __builtin_amdgcn_sched_barrier(0)
  int ui = 0, cpm, cpn, npm = 0, npn = 0;
  if ((int)blockIdx.x >= nU) return;
  unit_map(blockIdx.x, nM, nN, cpm, cpn, WGM);
  f32x4 acc[2][2][4][2];
#pragma unroll
  for (int a = 0; a < 2; ++a)
#pragma unroll
    for (int b = 0; b < 2; ++b)
#pragma unroll
      for (int m = 0; m < 4; ++m)
#pragma unroll
        for (int n = 0; n < 2; ++n) acc[a][b][m][n] = (f32x4){0.f, 0.f, 0.f, 0.f};
  bf16x8 At[4][2], B0[2][2], B1[2][2];
  const char* cA = (const char*)A + (size_t)cpm * tstepA; const char* cB = (const char*)Bt + (size_t)cpn * tstepB;
  P8_STAGE(P8_SB(0, 0), cB, voffB); P8_STAGE(P8_SA(0, 0), cA + ACOLB(0), voffA); P8_STAGE(P8_SB(0, 1), cB + hstepB, voffB); P8_STAGE(P8_SA(0, 1), cA + ACOLB(0) + hstepA, voffA);
  if (wr == 1) P8_BAR;
  P8_WAIT_V(4); P8_BAR;
  P8_STAGE(P8_SB(1, 0), cB + kstep, voffB); P8_STAGE(P8_SA(1, 0), cA + ACOLB(1), voffA); P8_STAGE(P8_SB(1, 1), cB + hstepB + kstep, voffB);
  P8_WAIT_V(6); P8_BAR;
  for (;;) {
    const int nu = (ui + 1) * G + (int)blockIdx.x;
    const bool has_next = nu < nU;
    if (has_next) unit_map(nu, nM, nN, npm, npn, WGM);
    const char* nA = has_next ? (const char*)A + (size_t)npm * tstepA : cA; const char* nB = has_next ? (const char*)Bt + (size_t)npn * tstepB : cB;
    for (int t = 0; t < nt; t += 2) {
      const bool last = (t == nt - 2);
      const char* a1 = cA + ACOLB(t + 1);
      const char* a2 = last ? nA + ACOLB(0) : cA + ACOLB(t + 2); const char* b2 = last ? nB : cB + (size_t)(t + 2) * kstep;
      const char* a3 = a2 + kstep; const char* b3 = b2 + kstep;
      P8_LDB(B0, 0, 0); P8_SCHED; P8_LDA(At, 0, 0); P8_STAGE(P8_SA(1, 1), a1 + hstepA, voffA);
      P8_WAIT_L(8); P8_BAR; P8_WAIT_L(0); P8_MMA(0, 0, At, B0); P8_BAR; P8_SCHED;
      P8_LDB(B1, 0, 1); P8_STAGE(P8_SB(0, 0), b2, voffB);
      P8_BAR; P8_WAIT_L(0); P8_MMA(0, 1, At, B1); P8_BAR;
      P8_LDA(At, 0, 1); P8_STAGE(P8_SA(0, 0), a2, voffA);
      P8_BAR; P8_WAIT_L(0); P8_MMA(1, 0, At, B0); P8_BAR; P8_SCHED;
      P8_STAGE(P8_SB(0, 1), b2 + hstepB, voffB);
      P8_WAIT_V(6); P8_BAR; P8_MMA(1, 1, At, B1); P8_BAR;
      P8_LDB(B0, 1, 0); P8_SCHED; P8_LDA(At, 1, 0); P8_STAGE(P8_SA(0, 1), a2 + hstepA, voffA);
      P8_WAIT_L(8); P8_BAR; P8_WAIT_L(0); P8_MMA(0, 0, At, B0); P8_BAR; P8_SCHED;
      P8_LDB(B1, 1, 1); P8_STAGE(P8_SB(1, 0), b3, voffB);
      P8_BAR; P8_WAIT_L(0); P8_MMA(0, 1, At, B1); P8_BAR;
      P8_LDA(At, 1, 1); P8_STAGE(P8_SA(1, 0), a3, voffA);
      P8_BAR; P8_WAIT_L(0); P8_MMA(1, 0, At, B0); P8_BAR; P8_SCHED;
      P8_STAGE(P8_SB(1, 1), b3 + hstepB, voffB);
      P8_WAIT_V(6); P8_BAR; P8_MMA(1, 1, At, B1); P8_BAR;
    }
    E(acc, cpm, cpn, wr, wc, fr, fq);
    if (!has_next) break;
#pragma unroll
    for (int a = 0; a < 2; ++a)
#pragma unroll
      for (int b = 0; b < 2; ++b)
#pragma unroll
        for (int m = 0; m < 4; ++m)
#pragma unroll
          for (int n = 0; n < 2; ++n) acc[a][b][m][n] = (f32x4){0.f, 0.f, 0.f, 0.f};
    cpm = npm; cpn = npn; cA = nA; cB = nB; ++ui;
  }
  P8_WAIT_V(0);
  if (wr == 0) P8_BAR;
  P8_BAR;
#undef ACOLB
#undef P8_SA
#undef P8_SB
#undef P8_STAGE
#undef P8_LDA
#undef P8_LDB
#undef P8_MMA
#undef P8_WAIT_V
#undef P8_WAIT_L
#undef P8_BAR
#undef P8_SCHED
}

struct Epi8InProj {
  const Params& p;
  __device__ __forceinline__ void operator()(f32x4 (&acc)[2][2][4][2], int pm, int pn, int wr, int wc, int fr, int fq) const {
    bf16_t* proj = (bf16_t*)(p.ws + OFF_PROJ);
    const f32x4* rotA = (const f32x4*)(p.ws + OFF_ROT);
    const f32x4* rotB = rotA + 128 * 32;
    const int kind = pn >> 1;
    const int head = wc >> 1, j0 = (wc & 1) * 32 + 8 * fq;
#pragma unroll
    for (int ai = 0; ai < 2; ++ai) {
      const int R0 = pm * 256 + ai * 128 + wr * 64 + fr;
      if (kind == 1 || kind == 2) {
        const float sc = (kind == 2) ? 0.08838834764831845f : 1.f;
        const int pos0 = row_pos(R0);
        f32x4 ra[4], rbb[2][4];
#pragma unroll
        for (int q = 0; q < 4; ++q) ra[q] = rotA[((pos0 >> 7) * 64 + j0) / 2 + q];
#pragma unroll
        for (int q = 0; q < 4; ++q) rbb[0][q] = rotB[((pos0 & 127) * 64 + j0) / 2 + q];
#pragma unroll
        for (int m = 0; m < 4; ++m) {
          const int R = R0 + 16 * m;
          if (m < 3) {
#pragma unroll
            for (int q = 0; q < 4; ++q) rbb[(m + 1) & 1][q] = rotB[(((pos0 + 16 * (m + 1)) & 127) * 64 + j0) / 2 + q];
          }
          const f32x4 (&rb)[4] = rbb[m & 1];
          float o1[8], o2[8];
#pragma unroll
          for (int e = 0; e < 8; ++e) {
            const float ca = ra[e >> 1][(e & 1) * 2], sa = ra[e >> 1][(e & 1) * 2 + 1], cb = rb[e >> 1][(e & 1) * 2], sb = rb[e >> 1][(e & 1) * 2 + 1];
            const float c = ca * cb - sa * sb, s = sa * cb + ca * sb;
            const float x1 = acc[ai][0][m][e >> 2][e & 3], x2 = acc[ai][1][m][e >> 2][e & 3];
            o1[e] = (x1 * c - x2 * s) * sc; o2[e] = (x1 * s + x2 * c) * sc;
          }
          bf16_t* rowp = proj + (size_t)R * INW + pn * 256 + head * 128 + j0;
          *(u32x4*)(rowp) = (u32x4){pack_bf16(o1[0], o1[1]), pack_bf16(o1[2], o1[3]), pack_bf16(o1[4], o1[5]), pack_bf16(o1[6], o1[7])};
          *(u32x4*)(rowp + 64) = (u32x4){pack_bf16(o2[0], o2[1]), pack_bf16(o2[2], o2[3]), pack_bf16(o2[4], o2[5]), pack_bf16(o2[6], o2[7])};
        }
      } else {
#pragma unroll
        for (int m = 0; m < 4; ++m) {
          bf16_t* rowp = proj + (size_t)(R0 + 16 * m) * INW + pn * 256 + head * 128 + j0;
#pragma unroll
          for (int bj = 0; bj < 2; ++bj) {
            f32x4 v0 = acc[ai][bj][m][0], v1 = acc[ai][bj][m][1];
            if (kind == 4) {
#pragma unroll
              for (int r = 0; r < 4; ++r) { v0[r] = silu_f(v0[r]); v1[r] = silu_f(v1[r]); }
            }
            *(u32x4*)(rowp + bj * 64) = (u32x4){pack_bf16(v0[0], v0[1]), pack_bf16(v0[2], v0[3]), pack_bf16(v1[0], v1[1]), pack_bf16(v1[2], v1[3])};
          }
        }
      }
    }
  }
};
template <int GT_OFF, bool INPLACE>
struct Epi8Resid {
  const Params& p;
  __device__ __forceinline__ void operator()(f32x4 (&acc)[2][2][4][2], int pm, int pn, int wr, int wc, int fr, int fq) const {
    const float* mod = (const float*)(p.ws + OFF_MOD);
    const int c0 = pn * 256 + wc * 32 + fq * 4;
    const float* gt = mod + row_batch(pm * 256) * 6144 + GT_OFF + c0;
    f32x4 g[2][2];
#pragma unroll
    for (int bj = 0; bj < 2; ++bj)
#pragma unroll
      for (int n = 0; n < 2; ++n) g[bj][n] = *(const f32x4*)(gt + bj * 128 + n * 16);
#pragma unroll
    for (int ai = 0; ai < 2; ++ai)
#pragma unroll
      for (int m = 0; m < 4; ++m) {
        const int R = pm * 256 + ai * 128 + wr * 64 + m * 16 + fr;
        const float* xr = (INPLACE ? (const float*)(p.out + (size_t)R * DM) : xrow(p, R)) + c0;
        float* orow = p.out + (size_t)R * DM + c0;
#pragma unroll
        for (int bj = 0; bj < 2; ++bj)
#pragma unroll
          for (int n = 0; n < 2; ++n) { const f32x4 xv = *(const f32x4*)(xr + bj * 128 + n * 16); *(f32x4*)(orow + bj * 128 + n * 16) = xv + g[bj][n] * acc[ai][bj][m][n]; }
      }
  }
};
struct Epi8OutProj {
  const Params& p;
  __device__ __forceinline__ void operator()(f32x4 (&acc)[2][2][4][2], int pm, int pn, int wr, int wc, int fr, int fq) const {
    const float* mod = (const float*)(p.ws + OFF_MOD) + row_batch(pm * 256) * 6144;
    const float* xbase = xrow(p, pm * 256);
    bf16_t* x1base = (bf16_t*)((char*)p.out + OUT_H) + (size_t)pm * 256 * DM;
    bf16_t* h2base = (bf16_t*)(p.ws + OFF_H2) + (size_t)pm * 256 * DM;
    float* ssq = (float*)(p.ws + OFF_SSQ) + pm * 256;
    const int c0 = pn * 256 + wc * 32 + fq * 8;
    const unsigned lo = (unsigned)((wr * 64 + fr) * DM + c0);
    float ssv[8];
#pragma unroll
    for (int gi = 0; gi < 8; ++gi) ssv[gi] = 0.f;
#pragma unroll
    for (int bj = 0; bj < 2; ++bj) {
      f32x4 g[2], a2[2];
#pragma unroll
      for (int n = 0; n < 2; ++n) {
        const int c = c0 + bj * 128 + n * 4;
        g[n] = *(const f32x4*)(mod + 2048 + c);
        a2[n] = *(const f32x4*)(p.norm_mlp + c) * (*(const f32x4*)(mod + 4096 + c) + 1.f);
      }
      f32x4 xv[2][2];
#pragma unroll
      for (int n = 0; n < 2; ++n) xv[0][n] = __builtin_nontemporal_load((const f32x4*)(xbase + lo + (unsigned)(bj * 128 + n * 4)));
#pragma unroll
      for (int gi = 0; gi < 8; ++gi) {
        const int ai = gi >> 2, m = gi & 3;
        if (gi < 7) {
#pragma unroll
          for (int n = 0; n < 2; ++n) xv[(gi + 1) & 1][n] = __builtin_nontemporal_load((const f32x4*)(xbase + lo + (unsigned)((((gi + 1) >> 2) * 128 + ((gi + 1) & 3) * 16) * DM + bj * 128 + n * 4)));
        }
        const unsigned ro = lo + (unsigned)((ai * 128 + m * 16) * DM + bj * 128);
        const f32x4 v0 = xv[gi & 1][0] + g[0] * acc[ai][bj][m][0], v1 = xv[gi & 1][1] + g[1] * acc[ai][bj][m][1];
        *(u32x4*)(x1base + ro) = (u32x4){pack_bf16(v0[0], v0[1]), pack_bf16(v0[2], v0[3]), pack_bf16(v1[0], v1[1]), pack_bf16(v1[2], v1[3])};
        ssv[gi] += (v0[0] * v0[0] + v0[1] * v0[1] + v0[2] * v0[2] + v0[3] * v0[3]) + (v1[0] * v1[0] + v1[1] * v1[1] + v1[2] * v1[2] + v1[3] * v1[3]);
        const f32x4 h0 = v0 * a2[0], h1 = v1 * a2[1];
        *(u32x4*)(h2base + ro) = (u32x4){pack_bf16(h0[0], h0[1]), pack_bf16(h0[2], h0[3]), pack_bf16(h1[0], h1[1]), pack_bf16(h1[2], h1[3])};
      }
    }
#pragma unroll
    for (int gi = 0; gi < 8; ++gi) {
      float ss = ssv[gi];
      ss += __shfl_xor(ss, 16); ss += __shfl_xor(ss, 32);
      if (fq == 0) atomicAdd(ssq + wr * 64 + fr + (gi >> 2) * 128 + (gi & 3) * 16, ss);
    }
  }
};
struct Epi8MlpOut {
  const Params& p;
  __device__ __forceinline__ void operator()(f32x4 (&acc)[2][2][4][2], int pm, int pn, int wr, int wc, int fr, int fq) const {
    const float* mod = (const float*)(p.ws + OFF_MOD);
    const int c0 = pn * 256 + wc * 32 + fq * 8;
    const float* gt = mod + row_batch(pm * 256) * 6144 + 5120 + c0;
    const bf16_t* x1base = (const bf16_t*)((const char*)p.out + OUT_H) + (size_t)pm * 256 * DM;
    bf16_t* x2base = (bf16_t*)(p.ws + OFF_H2) + (size_t)pm * 256 * DM;
    const unsigned lo = (unsigned)((wr * 64 + fr) * DM + c0);
    f32x4 g[2][2];
#pragma unroll
    for (int bj = 0; bj < 2; ++bj)
#pragma unroll
      for (int n = 0; n < 2; ++n) g[bj][n] = *(const f32x4*)(gt + bj * 128 + n * 4);
    u32x4 xv[2][2];
#pragma unroll
    for (int bj = 0; bj < 2; ++bj) xv[0][bj] = __builtin_nontemporal_load((const u32x4*)(x1base + lo + (unsigned)(bj * 128)));
#pragma unroll
    for (int gi = 0; gi < 8; ++gi) {
      const int ai = gi >> 2, m = gi & 3;
      if (gi < 7) {
#pragma unroll
        for (int bj = 0; bj < 2; ++bj) xv[(gi + 1) & 1][bj] = __builtin_nontemporal_load((const u32x4*)(x1base + lo + (unsigned)((((gi + 1) >> 2) * 128 + ((gi + 1) & 3) * 16) * DM + bj * 128)));
      }
      const unsigned ro = lo + (unsigned)((ai * 128 + m * 16) * DM);
#pragma unroll
      for (int bj = 0; bj < 2; ++bj) {
        const u32x4 xb = xv[gi & 1][bj];
        const f32x4 x0 = (f32x4){bf_lo(xb[0]), bf_hi(xb[0]), bf_lo(xb[1]), bf_hi(xb[1])}, x1 = (f32x4){bf_lo(xb[2]), bf_hi(xb[2]), bf_lo(xb[3]), bf_hi(xb[3])};
        const f32x4 v0 = x0 + g[bj][0] * acc[ai][bj][m][0], v1 = x1 + g[bj][1] * acc[ai][bj][m][1];
        *(u32x4*)(x2base + ro + bj * 128) = (u32x4){pack_bf16(v0[0], v0[1]), pack_bf16(v0[2], v0[3]), pack_bf16(v1[0], v1[1]), pack_bf16(v1[2], v1[3])};
      }
    }
  }
};
struct Epi8MlpIn {
  const Params& p;
  __device__ __forceinline__ void operator()(f32x4 (&acc)[2][2][4][2], int pm, int pn, int wr, int wc, int fr, int fq) const {
    bf16_t* hid = (bf16_t*)(p.ws + OFF_PROJ);
    const float* ssq = (const float*)(p.ws + OFF_SSQ);
    const int c0 = pn * 256 + wc * 32 + fq * 8;
    const float* b2 = (const float*)(p.ws + OFF_BIAS2) + row_batch(pm * 256) * DFF + c0;
    f32x4 bias[2][2];
#pragma unroll
    for (int bj = 0; bj < 2; ++bj)
#pragma unroll
      for (int n = 0; n < 2; ++n) bias[bj][n] = *(const f32x4*)(b2 + bj * 128 + n * 4);
    float rsv[8];
#pragma unroll
    for (int gi = 0; gi < 8; ++gi) rsv[gi] = ssq[pm * 256 + (gi >> 2) * 128 + wr * 64 + (gi & 3) * 16 + fr];
#pragma unroll
    for (int ai = 0; ai < 2; ++ai)
#pragma unroll
      for (int m = 0; m < 4; ++m) {
        const int R = pm * 256 + ai * 128 + wr * 64 + m * 16 + fr;
        const float rs = rsqrtf(rsv[ai * 4 + m] * (1.f / 1024.f) + 1e-6f);
        bf16_t* rowp = hid + (size_t)R * DFF + c0;
#pragma unroll
        for (int bj = 0; bj < 2; ++bj) {
          float v[8];
#pragma unroll
          for (int e = 0; e < 8; ++e) { const float t = fmaxf(acc[ai][bj][m][e >> 2][e & 3] * rs + bias[bj][e >> 2][e & 3], 0.f); v[e] = t * t; }
          __builtin_nontemporal_store((u32x4){pack_bf16(v[0], v[1]), pack_bf16(v[2], v[3]), pack_bf16(v[4], v[5]), pack_bf16(v[6], v[7])}, (u32x4*)(rowp + bj * 128));
        }
      }
  }
};

__device__ __forceinline__ int t_sw(int row) { return ((row & 3) << 2) | ((row >> 2) & 3); }
__device__ __forceinline__ int t_off(int row, int ch) { return 256 * row + 16 * (ch ^ t_sw(row)); }

__device__ __forceinline__ void tile_glds(lchar* dst, const bf16_t* src, size_t ld) {
  const int tid = threadIdx.x, wid = tid >> 6;
#pragma unroll
  for (int i = 0; i < 4; ++i) {
    const int L = i * 512 + tid, row = L >> 4, ch = (L & 15) ^ t_sw(row);
    __builtin_amdgcn_global_load_lds((const unsigned*)(src + (size_t)row * ld + ch * 8), (LAS unsigned*)(dst + (i * 512 + wid * 64) * 16), 16, 0, 0);
  }
}
__device__ __forceinline__ bf16x8 frag_row(const lchar* tile, int rbase, int ks, int fr, int fq) {
  return *(const LAS bf16x8*)(tile + t_off(rbase + fr, 4 * ks + fq));
}
__device__ __forceinline__ bf16x8 frag_tr(const lchar* tile, int c, int ks, int lane) {
  const int g = lane >> 4, q = (lane & 15) >> 2, pp = lane & 3;
  const int r0 = 32 * ks + 8 * g + q;
  s16x4 lo = __builtin_amdgcn_ds_read_tr16_b64_v4i16((LAS s16x4*)(tile + t_off(r0, 2 * c + (pp >> 1)) + 8 * (pp & 1)));
  s16x4 hi = __builtin_amdgcn_ds_read_tr16_b64_v4i16((LAS s16x4*)(tile + t_off(r0 + 4, 2 * c + (pp >> 1)) + 8 * (pp & 1)));
  return (bf16x8){lo[0], lo[1], lo[2], lo[3], hi[0], hi[1], hi[2], hi[3]};
}
template <bool ATR, bool BTR>
__device__ __forceinline__ void mm128(f32x4 (&acc)[2][4], const lchar* At, const lchar* Bt) {
  const int tid = threadIdx.x, wid = tid >> 6, lane = tid & 63, wr = wid >> 1, wc = wid & 1, fr = lane & 15, fq = lane >> 4;
  bf16x8 a[2][2], b[2][4];
#pragma unroll
  for (int m = 0; m < 2; ++m) a[0][m] = ATR ? frag_tr(At, wr * 2 + m, 0, lane) : frag_row(At, wr * 32 + m * 16, 0, fr, fq);
#pragma unroll
  for (int n = 0; n < 4; ++n) b[0][n] = BTR ? frag_tr(Bt, wc * 4 + n, 0, lane) : frag_row(Bt, wc * 64 + n * 16, 0, fr, fq);
#pragma unroll
  for (int ks = 0; ks < 4; ++ks) {
    const int c = ks & 1, d = c ^ 1;
    if (ks < 3) {
#pragma unroll
      for (int m = 0; m < 2; ++m) a[d][m] = ATR ? frag_tr(At, wr * 2 + m, ks + 1, lane) : frag_row(At, wr * 32 + m * 16, ks + 1, fr, fq);
#pragma unroll
      for (int n = 0; n < 4; ++n) b[d][n] = BTR ? frag_tr(Bt, wc * 4 + n, ks + 1, lane) : frag_row(Bt, wc * 64 + n * 16, ks + 1, fr, fq);
    }
#pragma unroll
    for (int m = 0; m < 2; ++m)
#pragma unroll
      for (int n = 0; n < 4; ++n) acc[m][n] = __builtin_amdgcn_mfma_f32_16x16x32_bf16(b[c][n], a[c][m], acc[m][n], 0, 0, 0);
    __builtin_amdgcn_sched_barrier(0);
  }
}
__device__ __forceinline__ void zero_acc(f32x4 (&acc)[2][4]) {
#pragma unroll
  for (int m = 0; m < 2; ++m)
#pragma unroll
    for (int n = 0; n < 4; ++n) acc[m][n] = (f32x4){0.f, 0.f, 0.f, 0.f};
}
__device__ __forceinline__ void acc_to_image(lchar* tile, const f32x4 (&acc)[2][4]) {
  const int tid = threadIdx.x, wid = tid >> 6, lane = tid & 63, wr = wid >> 1, wc = wid & 1, fr = lane & 15, fq = lane >> 4;
#pragma unroll
  for (int m = 0; m < 2; ++m)
#pragma unroll
    for (int n = 0; n < 4; ++n) {
      const int row = wr * 32 + m * 16 + fr, col = wc * 64 + n * 16 + fq * 4;
      *(LAS u32x2*)(tile + t_off(row, col >> 3) + (col & 7) * 2) = (u32x2){pack_bf16(acc[m][n][0], acc[m][n][1]), pack_bf16(acc[m][n][2], acc[m][n][3])};
    }
}

__device__ void transpose_item(const Params& p, lchar* shm, int t) {
  constexpr int T_IN = 16 * 10, T_OUT = 16 * 4, T_1 = 16 * 16;
  const int tid = threadIdx.x; char* ws = p.ws;
  const float* src; bf16_t* dst; int K, N, perm = 0;
  if (t < T_IN) { src = p.w_in; dst = (bf16_t*)(ws + OFF_WIN); K = 1024; N = INW; perm = 1; }
  else if ((t -= T_IN) < T_OUT) { src = p.w_out; dst = (bf16_t*)(ws + OFF_WOUT); K = 1024; N = 1024; perm = 2; }
  else if ((t -= T_OUT) < T_1) { src = p.w_mlp_in; dst = (bf16_t*)(ws + OFF_W1); K = 1024; N = DFF; perm = 2; }
  else { t -= T_1; src = p.w_mlp_out; dst = (bf16_t*)(ws + OFF_W2); K = DFF; N = 1024; perm = 2; }
  const int nNt = N / 256, k0 = (t / nNt) * 64, n0 = (t % nNt) * 256;
  LAS float* tl = (LAS float*)shm;
  f32x4 ld[8];
#pragma unroll
  for (int i = 0; i < 8; ++i) { const int kk = i * 8 + (tid >> 6), nn = (tid & 63) * 4; ld[i] = *(const f32x4*)(src + (size_t)(k0 + kk) * N + n0 + nn); }
#pragma unroll
  for (int i = 0; i < 8; ++i) { const int kk = i * 8 + (tid >> 6), nn = (tid & 63) * 4; tl[kk * 257 + nn] = ld[i][0]; tl[kk * 257 + nn + 1] = ld[i][1]; tl[kk * 257 + nn + 2] = ld[i][2]; tl[kk * 257 + nn + 3] = ld[i][3]; }
  __syncthreads();
#pragma unroll
  for (int q = 0; q < 4; ++q) {
    const int nn = q * 64 + (tid >> 3), kc = tid & 7;
    float v[8];
#pragma unroll
    for (int e = 0; e < 8; ++e) v[e] = tl[(kc * 8 + e) * 257 + nn];
    int nrow = n0 + nn;
    if (perm) {
      const int a = nrow & 255, ag = a >> 5, w = a & 31;
      const int rho = 16 * ((w >> 2) & 1) + 4 * (w >> 3) + (w & 3);
      const int gi = (perm == 1) ? (((ag >> 1) & 1) * 4 + (ag >> 2) * 2 + (ag & 1)) : ag;
      nrow = (nrow & ~255) + gi * 32 + rho;
    }
    *(u32x4*)(dst + (size_t)nrow * K + k0 + kc * 8) = (u32x4){pack_bf16(v[0], v[1]), pack_bf16(v[2], v[3]), pack_bf16(v[4], v[5]), pack_bf16(v[6], v[7])};
  }
  __syncthreads();
}
__device__ void late_transposes(const Params& p, lchar* shm) {
  const int half = gridDim.x >> 1;
  if ((int)blockIdx.x >= half) for (int t = 160 + (int)blockIdx.x - half; t < 160 + 576; t += (int)gridDim.x - half) transpose_item(p, shm, t);
}

__device__ void phase0a(const Params& p, lchar* shm) {
  const int tid = threadIdx.x, wid = tid >> 6, lane = tid & 63;
  const int gtid = (gridDim.x - 1 - blockIdx.x) * 512 + tid, gsz = gridDim.x * 512;
  char* ws = p.ws;
  {
    float2* rot = (float2*)(ws + OFF_ROT);
    bf16_t* ft = (bf16_t*)(ws + OFF_FTAB);
    float2* twp = (float2*)(ws + OFF_TWP);
    float2* tws = (float2*)(ws + OFF_TWS);
    float* gp = (float*)(ws + OFF_GPOW);
    constexpr int T0 = 16384, T1 = T0 + 5 * 16384, T2 = T1 + 16384, T3 = T2 + 2048, T4 = T3 + 2 * 4 * 132, T5 = T4 + NTOK;
    const int nthr = gsz > 160 * 512 ? 160 * 512 : gsz;
    if (gtid < nthr) for (int w = gtid; w < T5; w += nthr) {
      if (w < T0) {
        const int idx = w, which = idx >> 13, e = idx & 8191, a = e >> 6, j = e & 63;
        double inv = 1.0; for (int t = 0; t < j; ++t) inv *= 0.8659643233600653;
        const double ang = (which ? (double)a : 128.0 * (double)a) * inv;
        double s_, c_; sincos_d(ang, s_, c_);
        rot[idx] = make_float2((float)c_, (float)s_);
      } else if (w < T1) {
        const int idx = w - T0, t = idx >> 14, e = idx & 16383, row = e >> 7, col = e & 127;
        double s_, c_; float v;
        if (t < 3) { sincos_d(6.283185307179586476925 * (double)((row * col) & 127) / 128.0, s_, c_); v = (t == 0) ? (float)c_ : (t == 1 ? (float)(-s_) : (float)s_); }
        else { sincos_d(6.283185307179586476925 * (double)(((row & 15) * (col & 15)) & 15) / 16.0, s_, c_); v = ((row >> 4) == (col >> 4)) ? (t == 3 ? (float)c_ : (float)s_) : 0.f; }
        ft[idx] = (bf16_t)(pack_bf16(v, 0.f) & 0xffff);
      } else if (w < T2) {
        const int idx = w - T1; double s_, c_; sincos_d(6.283185307179586476925 * (double)idx / 16384.0, s_, c_);
        const double nrm = 1.0 / sqrt(16384.0 * 128.0);
        twp[idx] = make_float2((float)(c_ * nrm), (float)(-s_ * nrm));
      } else if (w < T3) {
        const int idx = w - T2; double s_, c_; sincos_d(6.283185307179586476925 * (double)idx / 2048.0, s_, c_);
        tws[idx] = make_float2((float)(c_ / 512.0), (float)(-s_ / 512.0));
      } else if (w < T4) {
        const int idx = w - T3, dir = idx / (4 * 132), h = (idx / 132) & 3, t = idx % 132;
        double e2 = 1.0 / 32.0; for (int i = 0; i < h; ++i) e2 *= 0.5;
        if (dir) e2 *= 0.70710678118654752440;
        const double g = 1.0 - e2; double v = 1.0; for (int i = 0; i < t; ++i) v *= g;
        gp[idx] = (float)v;
      } else {
        ((float*)(ws + OFF_SSQ))[w - T4] = 0.f;
      }
    }
  }
  {
    LAS f32x2* ctab = (LAS f32x2*)shm;
    if (tid < 128) { double s, c; sincos_d(6.283185307179586476925 * (double)tid / 128.0, s, c); ctab[tid] = (f32x2){(float)c, (float)s}; }
    __syncthreads();
    bf16_t* mt = (bf16_t*)(ws + OFF_MTAB);
    for (int idx = gtid; idx < 65536; idx += gsz) {
      const int g = idx >> 14, c = (idx >> 7) & 127, d = idx & 127;
      const float* W = p.w_fnet + (size_t)g * 16384 + d;
      float mr = 0.f, mi = 0.f;
#pragma unroll 32
      for (int cc = 0; cc < 128; ++cc) { const float w = W[cc * 128]; const f32x2 t = ctab[(c * cc) & 127]; mr += t.x * w; mi -= t.y * w; }
      const int drow = (d & ~31) + invperm32(invperm32(d & 31));
      mt[(size_t)(g * 2 + 0) * 16384 + drow * 128 + c] = (bf16_t)(pack_bf16(mr, 0.f) & 0xffff);
      mt[(size_t)(g * 2 + 1) * 16384 + drow * 128 + c] = (bf16_t)(pack_bf16(mi, 0.f) & 0xffff);
    }
    __syncthreads();
  }
  constexpr int N_GEMV = 96, T_IN = 16 * 10;
  for (int item = blockIdx.x; item < N_GEMV + T_IN; item += gridDim.x) {
    if (item < N_GEMV) {
      LAS float* sc = (LAS float*)shm;
      LAS float* red = (LAS float*)(shm + 49152);
      for (int i = tid; i < NB * 1024; i += 512) { const int b = i >> 10, k = i & 1023; const float v = b < 2 ? p.c_prompt[b * 1024 + k] : p.c_sample[(b - 2) * 1024 + k]; sc[k * 12 + b] = silu_f(v); }
      __syncthreads();
      const int col = item * 64 + lane;
      float a[NB];
#pragma unroll
      for (int b = 0; b < NB; ++b) a[b] = 0.f;
      for (int k0 = wid * 128; k0 < wid * 128 + 128; k0 += 32) {
        float w[32];
#pragma unroll
        for (int u = 0; u < 32; ++u) w[u] = p.ada_w[(size_t)(k0 + u) * 6144 + col];
#pragma unroll
        for (int u = 0; u < 32; ++u) {
          const f32x4 s0 = *(const LAS f32x4*)(sc + (k0 + u) * 12), s1 = *(const LAS f32x4*)(sc + (k0 + u) * 12 + 4), s2 = *(const LAS f32x4*)(sc + (k0 + u) * 12 + 8);
          a[0] += s0[0] * w[u]; a[1] += s0[1] * w[u]; a[2] += s0[2] * w[u]; a[3] += s0[3] * w[u];
          a[4] += s1[0] * w[u]; a[5] += s1[1] * w[u]; a[6] += s1[2] * w[u]; a[7] += s1[3] * w[u];
          a[8] += s2[0] * w[u]; a[9] += s2[1] * w[u];
        }
      }
#pragma unroll
      for (int b = 0; b < NB; ++b) red[(wid * NB + b) * 64 + lane] = a[b];
      __syncthreads();
      for (int i = tid; i < NB * 64; i += 512) {
        const int b = i >> 6, l = i & 63; float s = p.ada_b[item * 64 + l];
        for (int w = 0; w < 8; ++w) s += red[(w * NB + b) * 64 + l];
        ((float*)(ws + OFF_MOD))[b * 6144 + item * 64 + l] = s;
      }
      __syncthreads();
    } else {
      transpose_item(p, shm, item - N_GEMV);
    }
  }
}

__device__ void bias2_items(const Params& p, lchar* shm) {
  const int tid = threadIdx.x, wid = tid >> 6, lane = tid & 63;
  const float* mod = (const float*)(p.ws + OFF_MOD);
  const int first = (int)gridDim.x > 64 ? (int)gridDim.x - 64 : 0;
  for (int item = (int)blockIdx.x - first; item >= 0 && item < 64; item += (int)gridDim.x - first) {
    LAS float* sc = (LAS float*)shm;
    LAS float* red = (LAS float*)(shm + 40960);
    for (int i = tid; i < NB * 1024; i += 512) sc[i] = mod[(i >> 10) * 6144 + 3072 + (i & 1023)];
    __syncthreads();
    const int col = item * 64 + lane;
    float a[NB];
#pragma unroll
    for (int b = 0; b < NB; ++b) a[b] = 0.f;
    for (int k = wid * 128; k < wid * 128 + 128; ++k) {
      const float w = p.w_mlp_in[(size_t)k * DFF + col];
#pragma unroll
      for (int b = 0; b < NB; ++b) a[b] += sc[b * 1024 + k] * w;
    }
#pragma unroll
    for (int b = 0; b < NB; ++b) red[(wid * NB + b) * 64 + lane] = a[b];
    __syncthreads();
    for (int i = tid; i < NB * 64; i += 512) {
      const int b = i >> 6, l = i & 63; float sum = 0.f;
      for (int w = 0; w < 8; ++w) sum += red[(w * NB + b) * 64 + l];
      ((float*)(p.ws + OFF_BIAS2))[b * DFF + item * 64 + l] = sum;
    }
    __syncthreads();
  }
}

__device__ __forceinline__ void row_finish(const Params& p, int which, int R, const f32x4 (&v)[4], int lane) {
  const float* mod = (const float*)(p.ws + OFF_MOD);
  float ss = 0.f;
#pragma unroll
  for (int i = 0; i < 4; ++i) ss += v[i][0] * v[i][0] + v[i][1] * v[i][1] + v[i][2] * v[i][2] + v[i][3] * v[i][3];
#pragma unroll
  for (int o = 32; o > 0; o >>= 1) ss += __shfl_xor(ss, o);
  const float rs = rsqrtf(ss * (1.f / 1024.f) + 1e-6f);
  if (which == 2) {
#pragma unroll
    for (int i = 0; i < 4; ++i) { const f32x4 g = *(const f32x4*)(p.norm_final + i * 256 + lane * 4); __builtin_nontemporal_store(v[i] * rs * g, (f32x4*)(p.out + (size_t)R * DM + i * 256 + lane * 4)); }
  } else {
    const float* md = mod + row_batch(R) * 6144 + (which ? 3072 : 0);
    const float* gain = which ? p.norm_mlp : p.norm_mix;
    bf16_t* dst = which ? (bf16_t*)(p.ws + OFF_H2) : (bf16_t*)((char*)p.out + OUT_H);
#pragma unroll
    for (int i = 0; i < 4; ++i) {
      const int col = i * 256 + lane * 4;
      const f32x4 g = *(const f32x4*)(gain + col), sh = *(const f32x4*)(md + col), sc = *(const f32x4*)(md + 1024 + col);
      const f32x4 y = v[i] * rs * g * (sc + 1.f) + sh;
      *(u32x2*)(dst + (size_t)R * DM + col) = (u32x2){pack_bf16(y[0], y[1]), pack_bf16(y[2], y[3])};
    }
  }
}
__device__ void rows_phase(const Params& p, int which) {
  const int tid = threadIdx.x, lane = tid & 63;
  const int stride = gridDim.x * 8;
  for (int R0 = blockIdx.x * 8 + (tid >> 6); R0 < NTOK; R0 += 2 * stride) {
    const int Ra = (which == 2) ? NTOK - 1 - R0 : R0;
    const int R1 = R0 + stride; const bool two = R1 < NTOK;
    const int Rb = (which == 2) ? NTOK - 1 - R1 : R1;
    f32x4 va[4], vb[4];
    if (which == 2) {
      const bf16_t* x2 = (const bf16_t*)(p.ws + OFF_H2);
      u32x2 ua[4], ub[4];
#pragma unroll
      for (int i = 0; i < 4; ++i) ua[i] = __builtin_nontemporal_load((const u32x2*)(x2 + (size_t)Ra * DM + i * 256 + lane * 4));
#pragma unroll
      for (int i = 0; i < 4; ++i) ub[i] = __builtin_nontemporal_load((const u32x2*)(x2 + (size_t)(two ? Rb : Ra) * DM + i * 256 + lane * 4));
#pragma unroll
      for (int i = 0; i < 4; ++i) { va[i] = (f32x4){bf_lo(ua[i][0]), bf_hi(ua[i][0]), bf_lo(ua[i][1]), bf_hi(ua[i][1])}; vb[i] = (f32x4){bf_lo(ub[i][0]), bf_hi(ub[i][0]), bf_lo(ub[i][1]), bf_hi(ub[i][1])}; }
    } else {
      const float* sa = which ? p.out + (size_t)Ra * DM : xrow(p, Ra);
      const float* sb = two ? (which ? p.out + (size_t)Rb * DM : xrow(p, Rb)) : sa;
#pragma unroll
      for (int i = 0; i < 4; ++i) va[i] = __builtin_nontemporal_load((const f32x4*)(sa + i * 256 + lane * 4));
#pragma unroll
      for (int i = 0; i < 4; ++i) vb[i] = __builtin_nontemporal_load((const f32x4*)(sb + i * 256 + lane * 4));
    }
    row_finish(p, which, Ra, va, lane);
    if (two) row_finish(p, which, Rb, vb, lane);
  }
}

__device__ __forceinline__ void tile_load_regs(u32x4 (&v)[4], const bf16_t* src, size_t ld) {
  const int tid = threadIdx.x;
#pragma unroll
  for (int i = 0; i < 4; ++i) { const int L = i * 512 + tid, row = L >> 4, ch = L & 15; v[i] = *(const u32x4*)(src + (size_t)row * ld + ch * 8); }
}
__device__ __forceinline__ void tile_load_regs_nt(u32x4 (&v)[4], const bf16_t* src, size_t ld) {
  const int tid = threadIdx.x;
#pragma unroll
  for (int i = 0; i < 4; ++i) { const int L = i * 512 + tid, row = L >> 4, ch = L & 15; v[i] = __builtin_nontemporal_load((const u32x4*)(src + (size_t)row * ld + ch * 8)); }
}
__device__ __forceinline__ void tile_store_regs(lchar* dst, const u32x4 (&v)[4]) {
  const int tid = threadIdx.x;
#pragma unroll
  for (int i = 0; i < 4; ++i) { const int L = i * 512 + tid, row = L >> 4, ch = L & 15; *(LAS u32x4*)(dst + t_off(row, ch)) = v[i]; }
}
__device__ __forceinline__ void load_afrags(bf16x8 (&a)[2][4], const bf16_t* tab) {
  const int tid = threadIdx.x, wid = tid >> 6, lane = tid & 63, wr = wid >> 1, fr = lane & 15, fq = lane >> 4;
#pragma unroll
  for (int m = 0; m < 2; ++m)
#pragma unroll
    for (int ks = 0; ks < 4; ++ks) a[m][ks] = *(const bf16x8*)(tab + (wr * 32 + m * 16 + fr) * 128 + ks * 32 + fq * 8);
}
template <bool BTR>
__device__ __forceinline__ void mm128_areg(f32x4 (&acc)[2][4], const bf16x8 (&a)[2][4], const lchar* Bt) {
  const int tid = threadIdx.x, wid = tid >> 6, lane = tid & 63, wc = wid & 1, fr = lane & 15, fq = lane >> 4;
  bf16x8 b[2][4];
#pragma unroll
  for (int n = 0; n < 4; ++n) b[0][n] = BTR ? frag_tr(Bt, wc * 4 + n, 0, lane) : frag_row(Bt, wc * 64 + n * 16, 0, fr, fq);
#pragma unroll
  for (int ks = 0; ks < 4; ++ks) {
    const int c = ks & 1, d = c ^ 1;
    if (ks < 3) {
#pragma unroll
      for (int n = 0; n < 4; ++n) b[d][n] = BTR ? frag_tr(Bt, wc * 4 + n, ks + 1, lane) : frag_row(Bt, wc * 64 + n * 16, ks + 1, fr, fq);
    }
#pragma unroll
    for (int m = 0; m < 2; ++m)
#pragma unroll
      for (int n = 0; n < 4; ++n) acc[m][n] = __builtin_amdgcn_mfma_f32_16x16x32_bf16(b[c][n], a[m][ks], acc[m][n], 0, 0, 0);
    __builtin_amdgcn_sched_barrier(0);
  }
}

struct FftAItem { const bf16_t* src; size_t ld; const float2* tw; size_t tbase; int s2, ns2; };
__device__ __forceinline__ FftAItem ffta_item(const Params& p, int g, int j) {
  FftAItem it; const bf16_t* proj = (const bf16_t*)(p.ws + OFF_PROJ);
  if (j < 256) { const int b = j >> 7; it.s2 = j & 127; it.ns2 = 128; it.src = proj + (size_t)(b * 16384 + it.s2) * INW + g * 128; it.ld = (size_t)128 * INW;
    it.tw = (const float2*)(p.ws + OFF_TWP); it.tbase = (size_t)(b * 4 + g) * 128 * 128 * 128; }
  else { const int jj = j - 256, b = jj >> 4; it.s2 = jj & 15; it.ns2 = 16; it.src = proj + (size_t)(PROWS + b * 2048 + it.s2) * INW + g * 128; it.ld = (size_t)16 * INW;
    it.tw = (const float2*)(p.ws + OFF_TWS); it.tbase = (size_t)16777216 + (size_t)(b * 4 + g) * 128 * 16 * 128; }
  return it;
}
__device__ void phase2(const Params& p, lchar* shm) {
  const int tid = threadIdx.x, wid = tid >> 6, lane = tid & 63, wr = wid >> 1, wc = wid & 1, fr = lane & 15, fq = lane >> 4;
  lchar *R0 = shm, *R1 = shm + 32768, *R2 = shm + 65536, *R3 = shm + 98304;
  const bf16_t* proj = (const bf16_t*)(p.ws + OFF_PROJ);
  const bf16_t* ft = (const bf16_t*)(p.ws + OFF_FTAB);
  const bf16_t* mt = (const bf16_t*)(p.ws + OFF_MTAB);
  bf16_t* tre = (bf16_t*)((char*)p.out + OUT_H);
  bf16_t* tim = tre + (size_t)NTOK * 512;
  const float* gp = (const float*)(p.ws + OFF_GPOW);
  {
    const int g = blockIdx.x & 3, nper = gridDim.x >> 2, slot = blockIdx.x >> 2;
    if (slot < nper) {
      tile_glds(R2, mt + (size_t)(g * 2) * 16384, 128);
      tile_glds(R3, mt + (size_t)(g * 2 + 1) * 16384, 128);
      bf16x8 far[2][4], fai[2][4];
      load_afrags(far, ft); load_afrags(fai, ft + 16384);
      u32x4 xr[4];
      int j = slot;
      if (j < 384) { const FftAItem it = ffta_item(p, g, j); tile_load_regs_nt(xr, it.src, it.ld); }
      WAIT_V0(); __syncthreads();
      for (; j < 384; j += nper) {
        const FftAItem it = ffta_item(p, g, j);
        tile_store_regs(R0, xr);
        __syncthreads();
        if (j + nper < 384) { const FftAItem nx = ffta_item(p, g, j + nper); tile_load_regs_nt(xr, nx.src, nx.ld); }
        float2 twv[2];
#pragma unroll
        for (int m = 0; m < 2; ++m) twv[m] = it.tw[it.s2 * (wr * 32 + m * 16 + fr)];
        f32x4 ar[2][4], ai[2][4];
        zero_acc(ar); zero_acc(ai);
        mm128_areg<true>(ar, far, R0);
        mm128_areg<true>(ai, fai, R0);
#pragma unroll
        for (int m = 0; m < 2; ++m) {
          const float2 w = twv[m];
#pragma unroll
          for (int n = 0; n < 4; ++n)
#pragma unroll
            for (int r = 0; r < 4; ++r) { const float a = ar[m][n][r], bb = ai[m][n][r]; ar[m][n][r] = a * w.x - bb * w.y; ai[m][n][r] = a * w.y + bb * w.x; }
        }
        __syncthreads();
        acc_to_image(R0, ar); acc_to_image(R1, ai);
        __syncthreads();
        zero_acc(ar); zero_acc(ai);
        mm128<false, false>(ar, R0, R2);
        mm128<false, false>(ai, R1, R3);
#pragma unroll
        for (int m = 0; m < 2; ++m) {
          const int k1 = wr * 32 + m * 16 + fr;
          const size_t rb = it.tbase + ((size_t)k1 * it.ns2 + it.s2) * 128 + wc * 64 + fq * 8;
#pragma unroll
          for (int n2 = 0; n2 < 2; ++n2) {
            const f32x4 r0 = ar[m][2 * n2] - ai[m][2 * n2], r1 = ar[m][2 * n2 + 1] - ai[m][2 * n2 + 1];
            *(u32x4*)(tre + rb + n2 * 32) = (u32x4){pack_bf16(r0[0], r0[1]), pack_bf16(r0[2], r0[3]), pack_bf16(r1[0], r1[1]), pack_bf16(r1[2], r1[3])};
          }
        }
        zero_acc(ar);
        mm128<false, false>(ar, R0, R3);
        mm128<false, false>(ar, R1, R2);
#pragma unroll
        for (int m = 0; m < 2; ++m) {
          const int k1 = wr * 32 + m * 16 + fr;
          const size_t rb = it.tbase + ((size_t)k1 * it.ns2 + it.s2) * 128 + wc * 64 + fq * 8;
#pragma unroll
          for (int n2 = 0; n2 < 2; ++n2)
            *(u32x4*)(tim + rb + n2 * 32) = (u32x4){pack_bf16(ar[m][2 * n2][0], ar[m][2 * n2][1]), pack_bf16(ar[m][2 * n2][2], ar[m][2 * n2][3]), pack_bf16(ar[m][2 * n2 + 1][0], ar[m][2 * n2 + 1][1]), pack_bf16(ar[m][2 * n2 + 1][2], ar[m][2 * n2 + 1][3])};
        }
        __syncthreads();
      }
    }
  }
  {
    u32x4 kr[4], vr[4];
    float zfv[4], zbv[4];
    int it = blockIdx.x;
    if (it < 1536) { const bf16_t* kp = proj + (size_t)(it >> 2) * 128 * INW + 1024 + (it & 3) * 128; tile_load_regs_nt(kr, kp, INW); tile_load_regs_nt(vr, kp + 512, INW);
#pragma unroll
      for (int i = 0; i < 4; ++i) { const int row = (i * 512 + tid) >> 4; zfv[i] = gp[(it & 3) * 132 + 127 - row]; zbv[i] = gp[(4 + (it & 3)) * 132 + row]; } }
    for (; it < 1536; it += gridDim.x) {
      const int cidx = it >> 2, h = it & 3;
      tile_store_regs(R0, kr);
#pragma unroll
      for (int i = 0; i < 4; ++i) {
        const int L = i * 512 + tid, row = L >> 4, ch = L & 15;
        const float zf = zfv[i], zb = zbv[i];
        u32x4 of, ob;
#pragma unroll
        for (int e = 0; e < 4; ++e) { const float lo = bf_lo(vr[i][e]), hi = bf_hi(vr[i][e]); of[e] = pack_bf16(lo * zf, hi * zf); ob[e] = pack_bf16(lo * zb, hi * zb); }
        *(LAS u32x4*)(R1 + t_off(row, ch)) = of;
        *(LAS u32x4*)(R2 + t_off(row, ch)) = ob;
      }
      __syncthreads();
      if (it + (int)gridDim.x < 1536) { const int nx = it + gridDim.x; const bf16_t* kp = proj + (size_t)(nx >> 2) * 128 * INW + 1024 + (nx & 3) * 128; tile_load_regs_nt(kr, kp, INW); tile_load_regs_nt(vr, kp + 512, INW);
#pragma unroll
        for (int i = 0; i < 4; ++i) { const int row = (i * 512 + tid) >> 4; zfv[i] = gp[(nx & 3) * 132 + 127 - row]; zbv[i] = gp[(4 + (nx & 3)) * 132 + row]; } }
      f32x4 kf[2][4], kb[2][4];
      zero_acc(kf); zero_acc(kb);
      mm128<true, true>(kf, R0, R1);
      mm128<true, true>(kb, R0, R2);
      bf16_t* kvf = (bf16_t*)((char*)p.out + OUT_KV) + (size_t)(cidx * 4 + h) * 16384;
      bf16_t* kvb = kvf + (size_t)1536 * 16384;
#pragma unroll
      for (int m = 0; m < 2; ++m) {
        const int d = wr * 32 + m * 16 + fr;
#pragma unroll
        for (int n = 0; n < 4; ++n) {
          const int e = wc * 64 + n * 16 + fq * 4;
          *(u32x2*)(kvf + d * 128 + e) = (u32x2){pack_bf16(kf[m][n][0], kf[m][n][1]), pack_bf16(kf[m][n][2], kf[m][n][3])};
          *(u32x2*)(kvb + d * 128 + e) = (u32x2){pack_bf16(kb[m][n][0], kb[m][n][1]), pack_bf16(kb[m][n][2], kb[m][n][3])};
        }
      }
      __syncthreads();
    }
  }
}

__device__ void phase3(const Params& p, lchar* shm) {
  const int tid = threadIdx.x, wid = tid >> 6, lane = tid & 63, wr = wid >> 1, wc = wid & 1, fr = lane & 15, fq = lane >> 4;
  lchar *R0 = shm, *R1 = shm + 32768, *R2 = shm + 65536, *R3 = shm + 98304;
  bf16_t* proj = (bf16_t*)(p.ws + OFF_PROJ);
  const bf16_t* ft = (const bf16_t*)(p.ws + OFF_FTAB);
  const bf16_t* tre = (const bf16_t*)((char*)p.out + OUT_H);
  const bf16_t* tim = tre + (size_t)NTOK * 512;
  const float* gp = (const float*)(p.ws + OFF_GPOW);
  {
    const unsigned* kv = (const unsigned*)((char*)p.out + OUT_KV);
    unsigned* pv = (unsigned*)(p.ws + OFF_PREV);
    const int gtid = blockIdx.x * 512 + tid, gsz = gridDim.x * 512;
#if DBG == 17
    for (int rep = 0; rep < 2; ++rep)
#endif
    for (int w = gtid; w < 16 * 8192 + 64 * 8192; w += gsz) {
      int dir, h, c0, nch;
      const int pr = w & 8191;
      if (w < 16 * 8192) { const int ch = w >> 13; dir = ch >> 3; const int b = (ch >> 2) & 1; h = ch & 3; c0 = b * 128; nch = 128; }
      else { const int ch = (w >> 13) - 16; dir = ch >> 5; const int b = (ch >> 2) & 7; h = ch & 3; c0 = 256 + b * 16; nch = 16; }
      const float g = gp[(dir * 4 + h) * 132 + 128];
      const size_t boff = (size_t)dir * 1536 * 8192 + (size_t)h * 8192 + pr;
      const unsigned* base = kv + boff; unsigned* obase = pv + boff;
      float s0 = 0.f, s1 = 0.f;
      for (int n8 = 0; n8 < nch; n8 += 16) {
        unsigned t[16];
#pragma unroll
        for (int j = 0; j < 16; ++j) { const int n = dir ? (nch - 1 - (n8 + j)) : (n8 + j); t[j] = __builtin_nontemporal_load(base + (size_t)(c0 + n) * 4 * 8192); }
#pragma unroll
        for (int j = 0; j < 16; ++j) {
          const int n = dir ? (nch - 1 - (n8 + j)) : (n8 + j);
          obase[(size_t)(c0 + n) * 4 * 8192] = pack_bf16(s0, s1);
          s0 = s0 * g + bf_lo(t[j]); s1 = s1 * g + bf_hi(t[j]);
        }
      }
    }
  }
  {
    auto tb_of = [&](int item) -> size_t {
      if (item < 1024) { const int b = item >> 9, g = (item >> 7) & 3, k1 = item & 127; return ((size_t)(b * 4 + g) * 128 + k1) * 16384; }
      const int j = item - 1024, b = j >> 6, g = (j >> 4) & 3, kg = j & 15; return (size_t)16777216 + ((size_t)(b * 4 + g) * 128 + kg * 8) * 2048;
    };
    bf16x8 fa[2][4], fs[2][4];
    u32x4 tr[4], ti[4];
    int cur_tabs = -1;
    int item = blockIdx.x;
    if (item < 1536) { const size_t tb = tb_of(item); tile_load_regs_nt(tr, tre + tb, 128); tile_load_regs_nt(ti, tim + tb, 128); }
    for (; item < 1536; item += gridDim.x) {
      const int tabs = item < 1024 ? 0 : 1;
      if (tabs != cur_tabs) { load_afrags(fa, ft + (tabs ? 3 * 16384 : 0)); load_afrags(fs, ft + (tabs ? 4 * 16384 : 2 * 16384)); cur_tabs = tabs; }
      tile_store_regs(R0, tr); tile_store_regs(R1, ti);
      __syncthreads();
      if (item + (int)gridDim.x < 1536) { const size_t tb = tb_of(item + gridDim.x); tile_load_regs_nt(tr, tre + tb, 128); tile_load_regs_nt(ti, tim + tb, 128); }
      f32x4 y[2][4];
      zero_acc(y);
      mm128_areg<true>(y, fa, R0);
      mm128_areg<true>(y, fs, R1);
      int b, g, k1;
      if (item < 1024) { b = item >> 9; g = (item >> 7) & 3; k1 = item & 127; }
      else { const int j = item - 1024; b = j >> 6; g = (j >> 4) & 3; k1 = j & 15; }
#pragma unroll
      for (int m = 0; m < 2; ++m) {
        const int o = wr * 32 + m * 16 + fr;
        const int R = tabs ? (PROWS + b * 2048 + (k1 * 8 + (o >> 4)) + 128 * (o & 15)) : (b * 16384 + k1 + 128 * o);
        bf16_t* rowp = proj + (size_t)R * INW + g * 128 + wc * 64 + fq * 8;
#pragma unroll
        for (int n2 = 0; n2 < 2; ++n2)
          *(u32x4*)(rowp + n2 * 32) = (u32x4){pack_bf16(y[m][2 * n2][0], y[m][2 * n2][1]), pack_bf16(y[m][2 * n2][2], y[m][2 * n2][3]), pack_bf16(y[m][2 * n2 + 1][0], y[m][2 * n2 + 1][1]), pack_bf16(y[m][2 * n2 + 1][2], y[m][2 * n2 + 1][3])};
      }
      __syncthreads();
    }
  }
}

__device__ void phase4(const Params& p, lchar* shm, bool dummy = false) {
  const int tid = threadIdx.x, wid = tid >> 6, lane = tid & 63, wr = wid >> 1, wc = wid & 1, fr = lane & 15, fq = lane >> 4;
  lchar *R0 = shm, *R1 = shm + 32768, *R2 = shm + 65536, *R3 = shm + 98304;
  LAS float* xt = (LAS float*)(shm + 131072);
  LAS float* red = xt + 264;
  bf16_t* proj = (bf16_t*)(p.ws + OFF_PROJ);
  const float* gp = (const float*)(p.ws + OFF_GPOW);
  const bf16_t* kvall = (const bf16_t*)(p.ws + OFF_PREV);
  for (int item = blockIdx.x; item < 1536; item += gridDim.x) {
    const int cidx = item >> 2, h = item & 3;
    bf16_t* base = proj + (size_t)cidx * 128 * INW + h * 128;
    tile_glds(R0, base + 512, INW);
    tile_glds(R1, base + 1024, INW);
    tile_glds(R2, base + 1536, INW);
    tile_glds(R3, kvall + (size_t)(cidx * 4 + h) * 16384, 128);
    if (tid < 264) xt[tid] = gp[(tid < 132 ? h : 4 + h) * 132 + (tid < 132 ? tid : tid - 132)];
    WAIT_V0(); __syncthreads();
    f32x4 s[2][4], o[2][4];
    zero_acc(s); zero_acc(o);
    mm128<false, false>(s, R0, R1);
    mm128<false, true>(o, R0, R3);
    __syncthreads();
    tile_glds(R3, kvall + (size_t)(1536 + cidx * 4 + h) * 16384, 128);
#pragma unroll
    for (int m = 0; m < 2; ++m) {
      const int i = wr * 32 + m * 16 + fr;
      const float ratio = xt[i + 1] / xt[132 + 128 - i];
#pragma unroll
      for (int n = 0; n < 4; ++n)
#pragma unroll
        for (int r = 0; r < 4; ++r) {
          const int j = wc * 64 + n * 16 + fq * 4 + r, dd = i - j;
          s[m][n][r] *= (dd >= 0) ? xt[dd] : xt[132 - dd];
          o[m][n][r] *= ratio;
        }
    }
    acc_to_image(R1, s);
    u32x4 gw[4];
#pragma unroll
    for (int i = 0; i < 4; ++i) { const int L = i * 512 + tid; gw[i] = __builtin_nontemporal_load((const u32x4*)(base + (size_t)(L >> 4) * INW + 2048 + (L & 15) * 8)); }
    WAIT_V0(); __syncthreads();
    mm128<false, true>(o, R0, R3);
#pragma unroll
    for (int m = 0; m < 2; ++m) {
      const float xb = xt[132 + 128 - (wr * 32 + m * 16 + fr)];
#pragma unroll
      for (int n = 0; n < 4; ++n) o[m][n] *= xb;
    }
    mm128<false, true>(o, R1, R2);
    float ss[2];
#pragma unroll
    for (int m = 0; m < 2; ++m) {
      float a = 0.f;
#pragma unroll
      for (int n = 0; n < 4; ++n) a += o[m][n][0] * o[m][n][0] + o[m][n][1] * o[m][n][1] + o[m][n][2] * o[m][n][2] + o[m][n][3] * o[m][n][3];
      a += __shfl_xor(a, 16); a += __shfl_xor(a, 32);
      ss[m] = a;
      if (fq == 0) red[wc * 128 + wr * 32 + m * 16 + fr] = a;
    }
    __syncthreads();
#pragma unroll
    for (int m = 0; m < 2; ++m) {
      const int i = wr * 32 + m * 16 + fr;
      const float tot = red[i] + red[128 + i];
      const float rinv = rsqrtf(tot * (1.f / 128.f) + 1e-6f);
#pragma unroll
      for (int n = 0; n < 4; ++n) o[m][n] *= rinv;
    }
    (void)ss;
    acc_to_image(R0, o);
    __syncthreads();
#pragma unroll
    for (int i = 0; i < 4; ++i) {
      const int L = i * 512 + tid, row = L >> 4, ch = L & 15;
      const u32x4 rv = *(const LAS u32x4*)(R0 + t_off(row, ch));
      u32x4 ov;
#pragma unroll
      for (int e = 0; e < 4; ++e) ov[e] = pack_bf16(bf_lo(rv[e]) * bf_lo(gw[i][e]), bf_hi(rv[e]) * bf_hi(gw[i][e]));
      *(u32x4*)(base + (size_t)row * INW + 2048 + ch * 8) = ov;
    }
    __syncthreads();
  }
}

#define XB_TMO      128
#define XB_XCNT(j)  (256  + 64 * (j))
#define XB_XSUB(j)  (1280 + 64 * (j))
#define XB_XGEN(j)  (2304 + 64 * (j))
#define XB_TOP      3328
#define XB_TOPGEN   3392
#define XCD_BAR_WORDS 3456
#define XB_SPIN_CAP (1u << 18)
__device__ __forceinline__ unsigned xb_ld(unsigned* p)              { return __hip_atomic_load(p, __ATOMIC_RELAXED, __HIP_MEMORY_SCOPE_AGENT); }
__device__ __forceinline__ unsigned xb_add(unsigned* p, unsigned v) { return __hip_atomic_fetch_add(p, v, __ATOMIC_RELAXED, __HIP_MEMORY_SCOPE_AGENT); }
__device__ __forceinline__ unsigned xb_xcc_id() { return (unsigned)__builtin_amdgcn_s_getreg((3 << 11) | 20) & 0xFu; }
#define XB_SPIN(cond, bar) do { unsigned _sp = 0; while (cond) { __builtin_amdgcn_s_sleep(1); \
    if ((++_sp & 255u) == 0u) { if (xb_ld(&(bar)[XB_TMO])) break; if (_sp > XB_SPIN_CAP) { atomicAdd(&(bar)[XB_TMO], 1u); break; } } } } while (0)
struct XcdBarrier { unsigned* bar; unsigned x; volatile LAS unsigned* st; };
__device__ __forceinline__ XcdBarrier xcd_barrier_post(unsigned* bar, volatile LAS unsigned* st) {
  XcdBarrier b; b.bar = bar; b.x = xb_xcc_id(); b.st = st;
  if (threadIdx.x == 0) (void)xb_add(&bar[XB_XCNT(b.x)], 1u);
  return b;
}
__device__ __forceinline__ void xcd_barrier_complete(unsigned* bar, unsigned x, unsigned& nloc, unsigned& nx) {
  const unsigned G = gridDim.x * gridDim.y * gridDim.z;
  unsigned sum, cnt, mine, sp = 0u;
  for (;;) {
    sum = 0u; cnt = 0u; mine = 0u;
#pragma unroll
    for (unsigned j = 0; j < 16; ++j) { const unsigned c = xb_ld(&bar[XB_XCNT(j)]); sum += c; cnt += (c > 0u) ? 1u : 0u; mine = (j == x) ? c : mine; }
    if (sum == G) break;
    __builtin_amdgcn_s_sleep(1);
    if ((++sp & 255u) == 0u) { if (xb_ld(&bar[XB_TMO])) break; if (sp > XB_SPIN_CAP) { atomicAdd(&bar[XB_TMO], 1u); break; } }
  }
  nloc = mine > 0u ? mine : 1u; nx = cnt > 0u ? cnt : 1u;
}
__device__ __forceinline__ void xcd_barrier(const XcdBarrier& b) {
  asm volatile("s_waitcnt vmcnt(0)" ::: "memory");
  __syncthreads();
  if (threadIdx.x == 0) {
    unsigned* bar = b.bar;
    __builtin_amdgcn_s_waitcnt(0);
    unsigned nloc = b.st[0], nx = b.st[1];
    if (nloc == 0u) { xcd_barrier_complete(bar, b.x, nloc, nx); b.st[0] = nloc; b.st[1] = nx; }
    const unsigned old = xb_add(&bar[XB_XSUB(b.x)], 1u);
    const unsigned gen = old / nloc;
    if (old + 1u == (gen + 1u) * nloc) {
      __builtin_amdgcn_fence(__ATOMIC_RELEASE, "agent");
      asm volatile("s_waitcnt vmcnt(0)" ::: "memory");
      const unsigned og = xb_add(&bar[XB_TOP], 1u);
      const unsigned tg = og / nx;
      if (og + 1u == (tg + 1u) * nx) xb_add(&bar[XB_TOPGEN], 1u);
      else XB_SPIN(xb_ld(&bar[XB_TOPGEN]) == tg, bar);
      __builtin_amdgcn_fence(__ATOMIC_ACQUIRE, "agent");
      xb_add(&bar[XB_XGEN(b.x)], 1u);
      asm volatile("s_waitcnt vmcnt(0)" ::: "memory");
    } else {
      XB_SPIN(xb_ld(&bar[XB_XGEN(b.x)]) == gen, bar);
      __builtin_amdgcn_fence(__ATOMIC_ACQUIRE, "agent");
      asm volatile("s_waitcnt vmcnt(0)" ::: "memory");
    }
  }
  __syncthreads();
}

template <bool COOP>
__global__ void __launch_bounds__(512) mk_forward(Params p, int ph0, int ph1) {
  __shared__ __attribute__((aligned(1024))) char shm_[LDS_BYTES];
  lchar* shm = (lchar*)shm_;
#ifdef ONLY_PHASE
#define PH_ON(k) ((k) == ONLY_PHASE)
#else
#define PH_ON(k) (ph0 <= (k) && (k) <= ph1)
#endif
  XcdBarrier xb{};
  if (COOP) {
    volatile LAS unsigned* st = (volatile LAS unsigned*)(shm + 131072 + 3584);
    if (threadIdx.x == 0) { st[0] = 0u; st[1] = 0u; st[2] = 0u; st[3] = 0u; }
    __syncthreads();
    xb = xcd_barrier_post((unsigned*)(p.ws + OFF_BAR), st);
    if (ph1 > 1000) cg::this_grid().sync();
  }
#define PH_SYNC(k) do { if (COOP && ph0 <= (k) && (k) < ph1) xcd_barrier(xb); } while (0)
  if (PH_ON(0)) phase0a(p, shm);
#if DBG == 13
  __syncthreads();
  if (PH_ON(0)) phase0a(p, shm);
#endif
  PH_SYNC(0);
  if (PH_ON(1)) rows_phase(p, 0);
#if DBG == 14
  if (PH_ON(1)) rows_phase(p, 0);
#endif
  PH_SYNC(1);
  if (PH_ON(2)) gemm_phase8<4>(shm, (const bf16_t*)((const char*)p.out + OUT_H), DM, 1 << 30, 0, (const bf16_t*)(p.ws + OFF_WIN), DM, INW, Epi8InProj{p});
  if (PH_ON(2)) { __syncthreads(); bias2_items(p, shm); late_transposes(p, shm); }
#if DBG == 11
  __syncthreads();
  if (PH_ON(2)) gemm_phase8(shm, (const bf16_t*)((const char*)p.out + OUT_H), DM, 1 << 30, 0, (const bf16_t*)(p.ws + OFF_WIN), DM, INW, Epi8InProj{p});
#endif
  PH_SYNC(2);
  if (PH_ON(3)) phase2(p, shm);
#if DBG == 12
  __syncthreads();
  if (PH_ON(3)) phase2(p, shm);
#endif
  PH_SYNC(3);
  if (PH_ON(4)) phase3(p, shm);
  PH_SYNC(4);
#if DBG == 16
  if (PH_ON(5)) phase4(p, shm, true);
  __syncthreads();
#endif
  if (PH_ON(5)) phase4(p, shm);
  PH_SYNC(5);
  if (PH_ON(6)) gemm_phase8(shm, (const bf16_t*)(p.ws + OFF_PROJ), INW, 512, 1536, (const bf16_t*)(p.ws + OFF_WOUT), DM, DM, Epi8OutProj{p});
  PH_SYNC(6);
  if (PH_ON(8)) gemm_phase8<4>(shm, (const bf16_t*)(p.ws + OFF_H2), DM, 1 << 30, 0, (const bf16_t*)(p.ws + OFF_W1), DM, DFF, Epi8MlpIn{p});
#if DBG == 10
  __syncthreads();
  if (PH_ON(8)) gemm_phase8(shm, (const bf16_t*)(p.ws + OFF_H2), DM, 1 << 30, 0, (const bf16_t*)(p.ws + OFF_W1), DM, DFF, Epi8MlpIn{p});
#endif
  PH_SYNC(8);
  if (PH_ON(9)) gemm_phase8(shm, (const bf16_t*)(p.ws + OFF_PROJ), DFF, 1 << 30, 0, (const bf16_t*)(p.ws + OFF_W2), DFF, DM, Epi8MlpOut{p});
  PH_SYNC(9);
  if (PH_ON(10)) rows_phase(p, 2);
}

extern "C" void kernel_launch(void* const* d_in, const int* in_sizes, int n_in, void* d_out, int out_size, void* d_ws, size_t ws_size,
                              hipStream_t stream) {
  Params p{};
  p.x_prompt = (const float*)d_in[0]; p.x_sample = (const float*)d_in[1]; p.c_prompt = (const float*)d_in[2]; p.c_sample = (const float*)d_in[3];
  p.ada_w = (const float*)d_in[4]; p.ada_b = (const float*)d_in[5]; p.norm_mix = (const float*)d_in[6]; p.w_in = (const float*)d_in[7];
  p.w_fnet = (const float*)d_in[8]; p.w_out = (const float*)d_in[9]; p.norm_mlp = (const float*)d_in[10]; p.w_mlp_in = (const float*)d_in[11];
  p.w_mlp_out = (const float*)d_in[12]; p.norm_final = (const float*)d_in[13];
  p.out = (float*)d_out; p.ws = (char*)d_ws;
  if (ws_size < WS_END) { fprintf(stderr, "workspace too small: %zu < %zu\n", ws_size, (size_t)WS_END); return; }
#if MK_COOP
  static int grid_blocks = 0;
  if (!grid_blocks) {
    int dev = 0, cus = 0, per_cu = 0;
    hipGetDevice(&dev);
    hipDeviceGetAttribute(&cus, hipDeviceAttributeMultiprocessorCount, dev);
    hipOccupancyMaxActiveBlocksPerMultiprocessor(&per_cu, mk_forward<true>, 512, 0);
    if (per_cu > 1) per_cu = 1;
    grid_blocks = cus * per_cu;
  }
  hipMemsetAsync((char*)d_ws + OFF_BAR, 0, 3456 * 4, stream);
  int ph0 = 0, ph1 = 10;
  void* args[] = {&p, &ph0, &ph1};
  hipError_t e = hipLaunchCooperativeKernel((void*)mk_forward<true>, dim3(grid_blocks), dim3(512), args, 0, stream);
  if (e != hipSuccess) fprintf(stderr, "cooperative launch failed: %s (grid %d)\n", hipGetErrorString(e), grid_blocks);
#else
  for (int ph = 0; ph <= 10; ++ph) mk_forward<false><<<256, 512, 0, stream>>>(p, ph, ph);
#endif
}
```

```cpp
#include <hip/hip_runtime.h>
#include <hip/hip_cooperative_groups.h>
#include <cstdio>
namespace cg = cooperative_groups;

#ifndef DBG
#define DBG 0
#endif
#ifndef MK_COOP
#define MK_COOP 1
#endif

#define LAS __attribute__((address_space(3)))
typedef LAS char lchar;
typedef unsigned short bf16_t;
typedef short bf16x8 __attribute__((ext_vector_type(8)));
typedef short s16x4 __attribute__((ext_vector_type(4)));
typedef float f32x4 __attribute__((ext_vector_type(4)));
typedef unsigned u32x2 __attribute__((ext_vector_type(2)));
typedef float f32x2 __attribute__((ext_vector_type(2)));
typedef unsigned u32x4 __attribute__((ext_vector_type(4)));

constexpr int NTOK = 49152, DM = 1024, INW = 2560, DFF = 4096;
constexpr int PROWS = 32768;
constexpr int NB = 10;
constexpr int LDS_BYTES = 4 * 32768 + 4096;

constexpr size_t OFF_PROJ = 0;
constexpr size_t OFF_PREV = (size_t)NTOK * INW * 2;
constexpr size_t OFF_H2   = (size_t)NTOK * DFF * 2;
constexpr size_t OFF_WIN  = OFF_H2 + (size_t)NTOK * DM * 2;
constexpr size_t OFF_WOUT = OFF_WIN + (size_t)INW * DM * 2;
constexpr size_t OFF_W1   = OFF_WOUT + (size_t)DM * DM * 2;
constexpr size_t OFF_W2   = OFF_W1 + (size_t)DFF * DM * 2;
constexpr size_t OFF_MOD  = OFF_W2 + (size_t)DFF * DM * 2;
constexpr size_t OFF_ROT  = OFF_MOD + (size_t)NB * 6144 * 4;
constexpr size_t OFF_FTAB = OFF_ROT + 2 * 128 * 64 * 8;
constexpr size_t OFF_MTAB = OFF_FTAB + 5 * 32768;
constexpr size_t OFF_TWP  = OFF_MTAB + 8 * 32768;
constexpr size_t OFF_TWS  = OFF_TWP + 16384 * 8;
constexpr size_t OFF_GPOW = OFF_TWS + 2048 * 8;
constexpr size_t OFF_BAR  = (OFF_GPOW + 2 * 4 * 132 * 4 + 255) / 256 * 256;
constexpr size_t OFF_SSQ  = OFF_BAR + 3456 * 4;
constexpr size_t OFF_BIAS2 = OFF_SSQ + (size_t)NTOK * 16 * 4;
constexpr size_t WS_END   = OFF_BIAS2 + (size_t)NB * DFF * 4;
static_assert(WS_END <= (size_t)536870912, "workspace");
constexpr size_t OUT_H   = 0;
constexpr size_t OUT_KV  = (size_t)NTOK * DM * 2;

struct Params {
  const float *x_prompt, *x_sample, *c_prompt, *c_sample, *ada_w, *ada_b, *norm_mix, *w_in, *w_fnet, *w_out,
      *norm_mlp, *w_mlp_in, *w_mlp_out, *norm_final;
  float* out;
  char* ws;
};

__device__ __forceinline__ unsigned pack_bf16(float lo, float hi) {
  unsigned r; asm("v_cvt_pk_bf16_f32 %0, %1, %2" : "=v"(r) : "v"(lo), "v"(hi)); return r;
}
__device__ __forceinline__ float bf_lo(unsigned u) { return __uint_as_float(u << 16); }
__device__ __forceinline__ float bf_hi(unsigned u) { return __uint_as_float(u & 0xffff0000u); }
__device__ __forceinline__ int row_batch(int R) { return R < PROWS ? (R >> 14) : 2 + ((R - PROWS) >> 11); }
__device__ __forceinline__ int row_pos(int R) { return R < PROWS ? (R & 16383) : ((R - PROWS) & 2047); }
__device__ __forceinline__ const float* xrow(const Params& p, int R) {
  return R < PROWS ? p.x_prompt + (size_t)R * DM : p.x_sample + (size_t)(R - PROWS) * DM;
}
__device__ __forceinline__ float silu_f(float v) { return v / (1.f + __expf(-v)); }
#define WAIT_V0() asm volatile("s_waitcnt vmcnt(0)" ::: "memory")

__device__ void sincos_d(double x, double& s, double& c) {
  double q = rint(x * 0.63661977236758134308);
  double r = fma(-q, 1.57079632679489655800e+00, x);
  r = fma(-q, 6.12323399573676603587e-17, r);
  int qi = (int)(((long long)q) & 3);
  double r2 = r * r;
  double sp = r * (1.0 + r2 * (-1.0 / 6 + r2 * (1.0 / 120 + r2 * (-1.0 / 5040 + r2 * (1.0 / 362880 + r2 * (-1.0 / 39916800 + r2 * (1.0 / 6227020800.0)))))));
  double cp = 1.0 + r2 * (-0.5 + r2 * (1.0 / 24 + r2 * (-1.0 / 720 + r2 * (1.0 / 40320 + r2 * (-1.0 / 3628800 + r2 * (1.0 / 479001600.0 + r2 * (-1.0 / 87178291200.0)))))));
  if (qi == 0) { s = sp; c = cp; } else if (qi == 1) { s = cp; c = -sp; } else if (qi == 2) { s = -sp; c = -cp; } else { s = -cp; c = sp; }
}

__device__ __forceinline__ int lds_byte2(int r, int c) {
  int st = (r >> 4) * 2 + (c >> 5), ob = (r & 15) * 64 + (c & 31) * 2;
  return st * 1024 + (ob ^ (((ob >> 9) & 1) << 5));
}
__device__ __forceinline__ void stage_rc2(int b, int& R, int& C) {
  int st = b >> 10, sb = b & 1023, swz = sb ^ (((sb >> 9) & 1) << 5);
  R = (st >> 1) * 16 + swz / 64;
  C = (st & 1) * 32 + (swz % 64) / 2;
}
__device__ __forceinline__ void unit_map(int u, int nM, int nN, int& pm, int& pn) {
  int nwg = nM * nN, wgid = u;
  { int q = nwg / 8, r = nwg % 8, xcd = wgid % 8, off = wgid / 8; wgid = (xcd < r ? xcd * (q + 1) : r * (q + 1) + (xcd - r) * q) + off; }
  int nig = 8 * nN, gid = wgid / nig, fm = gid * 8, gsz = min(nM - fm, 8);
  pm = fm + ((wgid % nig) % gsz); pn = (wgid % nig) / gsz;
}

template <class Epi>
__device__ __forceinline__ void gemm_unit(lchar* shm, const bf16_t* __restrict__ A, int lda, int ksplit, int kjump,
                                          const bf16_t* __restrict__ Bt, int K, int pm, int pn, const Epi& epi) {
  constexpr int TILE_B = 256 * 64 * 2, STAGE_B = 2 * TILE_B;
  const int tid = threadIdx.x, wid = tid >> 6, lane = tid & 63, wr = wid >> 2, wc = wid & 3, fr = lane & 15, fq = lane >> 4;
  const bf16_t* Ab = A + (size_t)pm * 256 * lda;
  const bf16_t* Bb = Bt + (size_t)pn * 256 * K;
  int offA[4], offB[4];
#pragma unroll
  for (int i = 0; i < 4; ++i) { int r, c; stage_rc2(wid * 1024 + i * 8192 + lane * 16, r, c); offA[i] = r * lda + c; offB[i] = r * K + c; }
  f32x4 acc[8][4];
#pragma unroll
  for (int m = 0; m < 8; ++m)
#pragma unroll
    for (int n = 0; n < 4; ++n) acc[m][n] = (f32x4){0.f, 0.f, 0.f, 0.f};
  const int nt = K / 64;
#define G_STAGE(buf, kt) do { const int kc_ = (kt) * 64; const int ka_ = kc_ + (kc_ >= ksplit ? kjump : 0);            \
    _Pragma("unroll") for (int i = 0; i < 4; ++i) {                                                                    \
      __builtin_amdgcn_global_load_lds((const unsigned*)(Ab + offA[i] + ka_), (LAS unsigned*)(shm + (buf) * STAGE_B + wid * 1024 + i * 8192), 16, 0, 0); \
      __builtin_amdgcn_global_load_lds((const unsigned*)(Bb + offB[i] + kc_), (LAS unsigned*)(shm + (buf) * STAGE_B + TILE_B + wid * 1024 + i * 8192), 16, 0, 0); } } while (0)
  G_STAGE(0, 0); WAIT_V0(); __syncthreads();
  for (int t = 0; t < nt; ++t) {
    const int cur = t & 1;
    if (t + 1 < nt) G_STAGE(cur ^ 1, t + 1);
#pragma unroll
    for (int ks = 0; ks < 2; ++ks) {
      bf16x8 At[8], Bf[4];
#pragma unroll
      for (int m = 0; m < 8; ++m) At[m] = *(const LAS bf16x8*)(shm + cur * STAGE_B + lds_byte2(wr * 128 + m * 16 + fr, ks * 32 + fq * 8));
#pragma unroll
      for (int n = 0; n < 4; ++n) Bf[n] = *(const LAS bf16x8*)(shm + cur * STAGE_B + TILE_B + lds_byte2(wc * 64 + n * 16 + fr, ks * 32 + fq * 8));
#pragma unroll
      for (int m = 0; m < 8; ++m)
#pragma unroll
        for (int n = 0; n < 4; ++n) acc[m][n] = __builtin_amdgcn_mfma_f32_16x16x32_bf16(Bf[n], At[m], acc[m][n], 0, 0, 0);
      __builtin_amdgcn_sched_barrier(0);
    }
    WAIT_V0(); __syncthreads();
  }
#undef G_STAGE
  epi(acc, pm * 256 + wr * 128 + fr, pn, wc, fq);
}

struct EpiInProj {
  const Params& p;
  __device__ __forceinline__ void operator()(f32x4 (&acc)[8][4], int row0, int pn, int wc, int fq) const {
    bf16_t* proj = (bf16_t*)(p.ws + OFF_PROJ);
    const float2* rotA = (const float2*)(p.ws + OFF_ROT);
    const float2* rotB = rotA + 128 * 64;
    const int kind = pn >> 1;
    const int cbase = pn * 256 + (wc >> 1) * 128 + (wc & 1) * 32 + fq * 4;
#pragma unroll
    for (int m = 0; m < 8; ++m) {
      const int R = row0 + 16 * m;
      bf16_t* rowp = proj + (size_t)R * INW + cbase;
      if (kind == 1 || kind == 2) {
        const int pos = row_pos(R);
        const float sc = (kind == 2) ? 0.08838834764831845f : 1.f;
#pragma unroll
        for (int n = 0; n < 2; ++n) {
          const int j = (wc & 1) * 32 + n * 16 + fq * 4;
          f32x4 o1, o2;
#pragma unroll
          for (int r = 0; r < 4; ++r) {
            const float2 a = rotA[(pos >> 7) * 64 + j + r], b = rotB[(pos & 127) * 64 + j + r];
            const float c = a.x * b.x - a.y * b.y, s = a.y * b.x + a.x * b.y;
            const float x1 = acc[m][n][r], x2 = acc[m][n + 2][r];
            o1[r] = (x1 * c - x2 * s) * sc; o2[r] = (x1 * s + x2 * c) * sc;
          }
          *(u32x2*)(rowp + n * 16) = (u32x2){pack_bf16(o1[0], o1[1]), pack_bf16(o1[2], o1[3])};
          *(u32x2*)(rowp + 64 + n * 16) = (u32x2){pack_bf16(o2[0], o2[1]), pack_bf16(o2[2], o2[3])};
        }
      } else {
#pragma unroll
        for (int n = 0; n < 4; ++n) {
          f32x4 v = acc[m][n];
          if (kind == 4) { v[0] = silu_f(v[0]); v[1] = silu_f(v[1]); v[2] = silu_f(v[2]); v[3] = silu_f(v[3]); }
          *(u32x2*)(rowp + (n >> 1) * 64 + (n & 1) * 16) = (u32x2){pack_bf16(v[0], v[1]), pack_bf16(v[2], v[3])};
        }
      }
    }
  }
};
struct EpiOutProj {
  const Params& p;
  __device__ __forceinline__ void operator()(f32x4 (&acc)[8][4], int row0, int pn, int wc, int fq) const {
    const float* mod = (const float*)(p.ws + OFF_MOD);
    const int c0 = pn * 256 + wc * 64 + fq * 4;
    const float* gt = mod + row_batch(row0) * 6144 + 2048 + c0;
    f32x4 g[4];
#pragma unroll
    for (int n = 0; n < 4; ++n) g[n] = *(const f32x4*)(gt + n * 16);
#pragma unroll
    for (int m = 0; m < 8; ++m) {
      const int R = row0 + 16 * m;
      const float* xr = xrow(p, R) + c0;
      float* orow = p.out + (size_t)R * DM + c0;
#pragma unroll
      for (int n = 0; n < 4; ++n) { f32x4 xv = *(const f32x4*)(xr + n * 16); *(f32x4*)(orow + n * 16) = xv + g[n] * acc[m][n]; }
    }
  }
};
struct EpiMlpIn {
  const Params& p;
  __device__ __forceinline__ void operator()(f32x4 (&acc)[8][4], int row0, int pn, int wc, int fq) const {
    bf16_t* hid = (bf16_t*)(p.ws + OFF_PROJ);
    const int c0 = pn * 256 + wc * 64 + fq * 4;
#pragma unroll
    for (int m = 0; m < 8; ++m) {
      bf16_t* rowp = hid + (size_t)(row0 + 16 * m) * DFF + c0;
#pragma unroll
      for (int n = 0; n < 4; ++n) {
        f32x4 v = acc[m][n];
#pragma unroll
        for (int r = 0; r < 4; ++r) { float t = fmaxf(v[r], 0.f); v[r] = t * t; }
        *(u32x2*)(rowp + n * 16) = (u32x2){pack_bf16(v[0], v[1]), pack_bf16(v[2], v[3])};
      }
    }
  }
};
struct EpiMlpOut {
  const Params& p;
  __device__ __forceinline__ void operator()(f32x4 (&acc)[8][4], int row0, int pn, int wc, int fq) const {
    const float* mod = (const float*)(p.ws + OFF_MOD);
    const int c0 = pn * 256 + wc * 64 + fq * 4;
    const float* gt = mod + row_batch(row0) * 6144 + 5120 + c0;
    f32x4 g[4];
#pragma unroll
    for (int n = 0; n < 4; ++n) g[n] = *(const f32x4*)(gt + n * 16);
#pragma unroll
    for (int m = 0; m < 8; ++m) {
      float* orow = p.out + (size_t)(row0 + 16 * m) * DM + c0;
#pragma unroll
      for (int n = 0; n < 4; ++n) { f32x4 xv = *(const f32x4*)(orow + n * 16);
#if DBG == 3
        *(f32x4*)(orow + n * 16) = xv;
#else
        *(f32x4*)(orow + n * 16) = xv + g[n] * acc[m][n];
#endif
      }
    }
  }
};

template <class Epi>
__device__ __forceinline__ void gemm_phase(lchar* shm, const bf16_t* A, int lda, int ksplit, int kjump, const bf16_t* Bt, int K, int N, const Epi& epi) {
  const int nM = NTOK / 256, nN = N / 256;
  for (int u = blockIdx.x; u < nM * nN; u += gridDim.x) { int pm, pn; unit_map(u, nM, nN, pm, pn); gemm_unit(shm, A, lda, ksplit, kjump, Bt, K, pm, pn, epi); }
}


__device__ __forceinline__ int perm32(int rho) { const int n = rho >> 4, i = rho & 15; return 8 * (i >> 2) + 4 * n + (i & 3); }
__device__ __forceinline__ int invperm32(int w) { return 16 * ((w >> 2) & 1) + 4 * (w >> 3) + (w & 3); }
template <class Epi>
__device__ __forceinline__ void gemm_phase8(lchar* lds, const bf16_t* A, int lda, int ksplit, int kjump, const bf16_t* Bt, int K, int N, const Epi& E) {
  constexpr int HTB = 128 * 64 * 2;
  const int tid = threadIdx.x, wid = __builtin_amdgcn_readfirstlane(tid >> 6), lane = tid & 63, wr = wid >> 2, wc = wid & 3, fr = lane & 15, fq = lane >> 4;
  const int nt = K / 64, nM = NTOK / 256, nN = N / 256, nU = nM * nN, G = gridDim.x;
  unsigned voffA[2], voffB[2];
#pragma unroll
  for (int i = 0; i < 2; ++i) { int R, C; stage_rc2(tid * 16 + i * 8192, R, C); voffA[i] = (unsigned)(R * lda + C) * 2u; voffB[i] = (unsigned)(R * K + C) * 2u; }
  const size_t kstep = 128, hstepA = (size_t)128 * lda * 2, hstepB = (size_t)128 * K * 2, tstepA = 2 * hstepA, tstepB = 2 * hstepB;
  const unsigned ldsw = (unsigned)wid * 1024u;
  const int aoff = lds_byte2(wr * 64 + fr, fq * 8), boff = lds_byte2(wc * 32 + fr, fq * 8);
#define ACOLB(t) ((size_t)(((t) * 64 + (((t) * 64 >= ksplit) ? kjump : 0)) * 2))
#define P8_SA(b, h) (((b) * 2 + (h)) * HTB)
#define P8_SB(b, h) ((4 + (b) * 2 + (h)) * HTB)
#define P8_STAGE(bufoff, gbase, voff) do { _Pragma("unroll") for (int _i = 0; _i < 2; ++_i) \
    __builtin_amdgcn_global_load_lds((const unsigned*)((const char*)(gbase) + (voff)[_i]), (LAS unsigned*)(lds + (bufoff) + ldsw + _i * 8192), 16, 0, 0); } while (0)
#define P8_LDA(dst, b, h) do { _Pragma("unroll") for (int m = 0; m < 4; ++m) _Pragma("unroll") for (int k = 0; k < 2; ++k) dst[m][k] = *(const LAS bf16x8*)(lds + P8_SA(b, h) + aoff + m * 2048 + k * 1024); } while (0)
#define P8_LDB(dst, b, h) do { _Pragma("unroll") for (int n = 0; n < 2; ++n) _Pragma("unroll") for (int k = 0; k < 2; ++k) dst[n][k] = *(const LAS bf16x8*)(lds + P8_SB(b, h) + boff + n * 2048 + k * 1024); } while (0)
#define P8_MMA(ai, bj, At_, Bt_) do { __builtin_amdgcn_s_setprio(1); _Pragma("unroll") for (int m = 0; m < 4; ++m) _Pragma("unroll") for (int n = 0; n < 2; ++n) _Pragma("unroll") for (int k = 0; k < 2; ++k) \
    acc[ai][bj][m][n] = __builtin_amdgcn_mfma_f32_16x16x32_bf16(Bt_[n][k], At_[m][k], acc[ai][bj][m][n], 0, 0, 0); __builtin_amdgcn_s_setprio(0); } while (0)
#define P8_WAIT_V(n) asm volatile("s_waitcnt vmcnt(" #n ")" ::: "memory")
#define P8_WAIT_L(n) asm volatile("s_waitcnt lgkmcnt(" #n ")" ::: "memory")
#define P8_BAR __builtin_amdgcn_s_barrier()
#define P8_SCHED __builtin_amdgcn_sched_barrier(0)
  int ui = 0, cpm, cpn, npm = 0, npn = 0;
  if ((int)blockIdx.x >= nU) return;
  unit_map(blockIdx.x, nM, nN, cpm, cpn);
  f32x4 acc[2][2][4][2];
#pragma unroll
  for (int a = 0; a < 2; ++a)
#pragma unroll
    for (int b = 0; b < 2; ++b)
#pragma unroll
      for (int m = 0; m < 4; ++m)
#pragma unroll
        for (int n = 0; n < 2; ++n) acc[a][b][m][n] = (f32x4){0.f, 0.f, 0.f, 0.f};
  bf16x8 At[4][2], B0[2][2], B1[2][2];
  const char* cA = (const char*)A + (size_t)cpm * tstepA; const char* cB = (const char*)Bt + (size_t)cpn * tstepB;
  P8_STAGE(P8_SB(0, 0), cB, voffB); P8_STAGE(P8_SA(0, 0), cA + ACOLB(0), voffA); P8_STAGE(P8_SB(0, 1), cB + hstepB, voffB); P8_STAGE(P8_SA(0, 1), cA + ACOLB(0) + hstepA, voffA);
  if (wr == 1) P8_BAR;
  P8_WAIT_V(4); P8_BAR;
  P8_STAGE(P8_SB(1, 0), cB + kstep, voffB); P8_STAGE(P8_SA(1, 0), cA + ACOLB(1), voffA); P8_STAGE(P8_SB(1, 1), cB + hstepB + kstep, voffB);
  P8_WAIT_V(6); P8_BAR;
  for (;;) {
    const int nu = (ui + 1) * G + (int)blockIdx.x;
    const bool has_next = nu < nU;
    if (has_next) unit_map(nu, nM, nN, npm, npn);
    const char* nA = has_next ? (const char*)A + (size_t)npm * tstepA : cA; const char* nB = has_next ? (const char*)Bt + (size_t)npn * tstepB : cB;
    for (int t = 0; t < nt; t += 2) {
      const bool last = (t == nt - 2);
      const char* a1 = cA + ACOLB(t + 1);
      const char* a2 = last ? nA + ACOLB(0) : cA + ACOLB(t + 2); const char* b2 = last ? nB : cB + (size_t)(t + 2) * kstep;
      const char* a3 = a2 + kstep; const char* b3 = b2 + kstep;
      P8_LDB(B0, 0, 0); P8_SCHED; P8_LDA(At, 0, 0); P8_STAGE(P8_SA(1, 1), a1 + hstepA, voffA);
      P8_WAIT_L(8); P8_BAR; P8_WAIT_L(0); P8_MMA(0, 0, At, B0); P8_BAR; P8_SCHED;
      P8_LDB(B1, 0, 1); P8_STAGE(P8_SB(0, 0), b2, voffB);
      P8_BAR; P8_WAIT_L(0); P8_MMA(0, 1, At, B1); P8_BAR;
      P8_LDA(At, 0, 1); P8_STAGE(P8_SA(0, 0), a2, voffA);
      P8_BAR; P8_WAIT_L(0); P8_MMA(1, 0, At, B0); P8_BAR; P8_SCHED;
      P8_STAGE(P8_SB(0, 1), b2 + hstepB, voffB);
      P8_WAIT_V(6); P8_BAR; P8_MMA(1, 1, At, B1); P8_BAR;
      P8_LDB(B0, 1, 0); P8_SCHED; P8_LDA(At, 1, 0); P8_STAGE(P8_SA(0, 1), a2 + hstepA, voffA);
      P8_WAIT_L(8); P8_BAR; P8_WAIT_L(0); P8_MMA(0, 0, At, B0); P8_BAR; P8_SCHED;
      P8_LDB(B1, 1, 1); P8_STAGE(P8_SB(1, 0), b3, voffB);
      P8_BAR; P8_WAIT_L(0); P8_MMA(0, 1, At, B1); P8_BAR;
      P8_LDA(At, 1, 1); P8_STAGE(P8_SA(1, 0), a3, voffA);
      P8_BAR; P8_WAIT_L(0); P8_MMA(1, 0, At, B0); P8_BAR; P8_SCHED;
      P8_STAGE(P8_SB(1, 1), b3 + hstepB, voffB);
      P8_WAIT_V(6); P8_BAR; P8_MMA(1, 1, At, B1); P8_BAR;
    }
    E(acc, cpm, cpn, wr, wc, fr, fq);
    if (!has_next) break;
#pragma unroll
    for (int a = 0; a < 2; ++a)
#pragma unroll
      for (int b = 0; b < 2; ++b)
#pragma unroll
        for (int m = 0; m < 4; ++m)
#pragma unroll
          for (int n = 0; n < 2; ++n) acc[a][b][m][n] = (f32x4){0.f, 0.f, 0.f, 0.f};
    cpm = npm; cpn = npn; cA = nA; cB = nB; ++ui;
  }
  P8_WAIT_V(0);
  if (wr == 0) P8_BAR;
  P8_BAR;
#undef ACOLB
#undef P8_SA
#undef P8_SB
#undef P8_STAGE
#undef P8_LDA
#undef P8_LDB
#undef P8_MMA
#undef P8_WAIT_V
#undef P8_WAIT_L
#undef P8_BAR
#undef P8_SCHED
}

struct Epi8InProj {
  const Params& p;
  __device__ __forceinline__ void operator()(f32x4 (&acc)[2][2][4][2], int pm, int pn, int wr, int wc, int fr, int fq) const {
    bf16_t* proj = (bf16_t*)(p.ws + OFF_PROJ);
    const f32x4* rotA = (const f32x4*)(p.ws + OFF_ROT);
    const f32x4* rotB = rotA + 128 * 32;
    const int kind = pn >> 1;
    const int head = wc >> 1, j0 = (wc & 1) * 32 + 8 * fq;
#pragma unroll
    for (int ai = 0; ai < 2; ++ai) {
      const int R0 = pm * 256 + ai * 128 + wr * 64 + fr;
      if (kind == 1 || kind == 2) {
        const float sc = (kind == 2) ? 0.08838834764831845f : 1.f;
        const int pos0 = row_pos(R0);
        f32x4 ra[4], rbb[2][4];
#pragma unroll
        for (int q = 0; q < 4; ++q) ra[q] = rotA[((pos0 >> 7) * 64 + j0) / 2 + q];
#pragma unroll
        for (int q = 0; q < 4; ++q) rbb[0][q] = rotB[((pos0 & 127) * 64 + j0) / 2 + q];
#pragma unroll
        for (int m = 0; m < 4; ++m) {
          const int R = R0 + 16 * m;
          if (m < 3) {
#pragma unroll
            for (int q = 0; q < 4; ++q) rbb[(m + 1) & 1][q] = rotB[(((pos0 + 16 * (m + 1)) & 127) * 64 + j0) / 2 + q];
          }
          const f32x4 (&rb)[4] = rbb[m & 1];
          float o1[8], o2[8];
#pragma unroll
          for (int e = 0; e < 8; ++e) {
            const float ca = ra[e >> 1][(e & 1) * 2], sa = ra[e >> 1][(e & 1) * 2 + 1], cb = rb[e >> 1][(e & 1) * 2], sb = rb[e >> 1][(e & 1) * 2 + 1];
            const float c = ca * cb - sa * sb, s = sa * cb + ca * sb;
            const float x1 = acc[ai][0][m][e >> 2][e & 3], x2 = acc[ai][1][m][e >> 2][e & 3];
            o1[e] = (x1 * c - x2 * s) * sc; o2[e] = (x1 * s + x2 * c) * sc;
          }
          bf16_t* rowp = proj + (size_t)R * INW + pn * 256 + head * 128 + j0;
          *(u32x4*)(rowp) = (u32x4){pack_bf16(o1[0], o1[1]), pack_bf16(o1[2], o1[3]), pack_bf16(o1[4], o1[5]), pack_bf16(o1[6], o1[7])};
          *(u32x4*)(rowp + 64) = (u32x4){pack_bf16(o2[0], o2[1]), pack_bf16(o2[2], o2[3]), pack_bf16(o2[4], o2[5]), pack_bf16(o2[6], o2[7])};
        }
      } else {
#pragma unroll
        for (int m = 0; m < 4; ++m) {
          bf16_t* rowp = proj + (size_t)(R0 + 16 * m) * INW + pn * 256 + head * 128 + j0;
#pragma unroll
          for (int bj = 0; bj < 2; ++bj) {
            f32x4 v0 = acc[ai][bj][m][0], v1 = acc[ai][bj][m][1];
            if (kind == 4) {
#pragma unroll
              for (int r = 0; r < 4; ++r) { v0[r] = silu_f(v0[r]); v1[r] = silu_f(v1[r]); }
            }
            *(u32x4*)(rowp + bj * 64) = (u32x4){pack_bf16(v0[0], v0[1]), pack_bf16(v0[2], v0[3]), pack_bf16(v1[0], v1[1]), pack_bf16(v1[2], v1[3])};
          }
        }
      }
    }
  }
};
template <int GT_OFF, bool INPLACE>
struct Epi8Resid {
  const Params& p;
  __device__ __forceinline__ void operator()(f32x4 (&acc)[2][2][4][2], int pm, int pn, int wr, int wc, int fr, int fq) const {
    const float* mod = (const float*)(p.ws + OFF_MOD);
    const int c0 = pn * 256 + wc * 32 + fq * 4;
    const float* gt = mod + row_batch(pm * 256) * 6144 + GT_OFF + c0;
    f32x4 g[2][2];
#pragma unroll
    for (int bj = 0; bj < 2; ++bj)
#pragma unroll
      for (int n = 0; n < 2; ++n) g[bj][n] = *(const f32x4*)(gt + bj * 128 + n * 16);
#pragma unroll
    for (int ai = 0; ai < 2; ++ai)
#pragma unroll
      for (int m = 0; m < 4; ++m) {
        const int R = pm * 256 + ai * 128 + wr * 64 + m * 16 + fr;
        const float* xr = (INPLACE ? (const float*)(p.out + (size_t)R * DM) : xrow(p, R)) + c0;
        float* orow = p.out + (size_t)R * DM + c0;
#pragma unroll
        for (int bj = 0; bj < 2; ++bj)
#pragma unroll
          for (int n = 0; n < 2; ++n) { const f32x4 xv = *(const f32x4*)(xr + bj * 128 + n * 16); *(f32x4*)(orow + bj * 128 + n * 16) = xv + g[bj][n] * acc[ai][bj][m][n]; }
      }
  }
};
struct Epi8OutProj {
  const Params& p;
  __device__ __forceinline__ void operator()(f32x4 (&acc)[2][2][4][2], int pm, int pn, int wr, int wc, int fr, int fq) const {
    const float* mod = (const float*)(p.ws + OFF_MOD) + row_batch(pm * 256) * 6144;
    const float* xbase = xrow(p, pm * 256);
    bf16_t* x1base = (bf16_t*)((char*)p.out + OUT_H) + (size_t)pm * 256 * DM;
    bf16_t* h2base = (bf16_t*)(p.ws + OFF_H2) + (size_t)pm * 256 * DM;
    float* ssq = (float*)(p.ws + OFF_SSQ) + pm * 256;
    const int c0 = pn * 256 + wc * 32 + fq * 8;
    const unsigned lo = (unsigned)((wr * 64 + fr) * DM + c0);
    float ssv[8];
#pragma unroll
    for (int gi = 0; gi < 8; ++gi) ssv[gi] = 0.f;
#pragma unroll
    for (int bj = 0; bj < 2; ++bj) {
      f32x4 g[2], a2[2];
#pragma unroll
      for (int n = 0; n < 2; ++n) {
        const int c = c0 + bj * 128 + n * 4;
        g[n] = *(const f32x4*)(mod + 2048 + c);
        a2[n] = *(const f32x4*)(p.norm_mlp + c) * (*(const f32x4*)(mod + 4096 + c) + 1.f);
      }
      f32x4 xv[2][2];
#pragma unroll
      for (int n = 0; n < 2; ++n) xv[0][n] = __builtin_nontemporal_load((const f32x4*)(xbase + lo + (unsigned)(bj * 128 + n * 4)));
#pragma unroll
      for (int gi = 0; gi < 8; ++gi) {
        const int ai = gi >> 2, m = gi & 3;
        if (gi < 7) {
#pragma unroll
          for (int n = 0; n < 2; ++n) xv[(gi + 1) & 1][n] = __builtin_nontemporal_load((const f32x4*)(xbase + lo + (unsigned)((((gi + 1) >> 2) * 128 + ((gi + 1) & 3) * 16) * DM + bj * 128 + n * 4)));
        }
        const unsigned ro = lo + (unsigned)((ai * 128 + m * 16) * DM + bj * 128);
        const f32x4 v0 = xv[gi & 1][0] + g[0] * acc[ai][bj][m][0], v1 = xv[gi & 1][1] + g[1] * acc[ai][bj][m][1];
        *(u32x4*)(x1base + ro) = (u32x4){pack_bf16(v0[0], v0[1]), pack_bf16(v0[2], v0[3]), pack_bf16(v1[0], v1[1]), pack_bf16(v1[2], v1[3])};
        ssv[gi] += (v0[0] * v0[0] + v0[1] * v0[1] + v0[2] * v0[2] + v0[3] * v0[3]) + (v1[0] * v1[0] + v1[1] * v1[1] + v1[2] * v1[2] + v1[3] * v1[3]);
        const f32x4 h0 = v0 * a2[0], h1 = v1 * a2[1];
        *(u32x4*)(h2base + ro) = (u32x4){pack_bf16(h0[0], h0[1]), pack_bf16(h0[2], h0[3]), pack_bf16(h1[0], h1[1]), pack_bf16(h1[2], h1[3])};
      }
    }
#pragma unroll
    for (int gi = 0; gi < 8; ++gi) {
      float ss = ssv[gi];
      ss += __shfl_xor(ss, 16); ss += __shfl_xor(ss, 32);
      if (fq == 0) atomicAdd(ssq + wr * 64 + fr + (gi >> 2) * 128 + (gi & 3) * 16, ss);
    }
  }
};
struct Epi8MlpOut {
  const Params& p;
  __device__ __forceinline__ void operator()(f32x4 (&acc)[2][2][4][2], int pm, int pn, int wr, int wc, int fr, int fq) const {
    const float* mod = (const float*)(p.ws + OFF_MOD);
    const int c0 = pn * 256 + wc * 32 + fq * 8;
    const float* gt = mod + row_batch(pm * 256) * 6144 + 5120 + c0;
    const bf16_t* x1base = (const bf16_t*)((const char*)p.out + OUT_H) + (size_t)pm * 256 * DM;
    bf16_t* x2base = (bf16_t*)(p.ws + OFF_H2) + (size_t)pm * 256 * DM;
    const unsigned lo = (unsigned)((wr * 64 + fr) * DM + c0);
    f32x4 g[2][2];
#pragma unroll
    for (int bj = 0; bj < 2; ++bj)
#pragma unroll
      for (int n = 0; n < 2; ++n) g[bj][n] = *(const f32x4*)(gt + bj * 128 + n * 4);
    u32x4 xv[2][2];
#pragma unroll
    for (int bj = 0; bj < 2; ++bj) xv[0][bj] = __builtin_nontemporal_load((const u32x4*)(x1base + lo + (unsigned)(bj * 128)));
#pragma unroll
    for (int gi = 0; gi < 8; ++gi) {
      const int ai = gi >> 2, m = gi & 3;
      if (gi < 7) {
#pragma unroll
        for (int bj = 0; bj < 2; ++bj) xv[(gi + 1) & 1][bj] = __builtin_nontemporal_load((const u32x4*)(x1base + lo + (unsigned)((((gi + 1) >> 2) * 128 + ((gi + 1) & 3) * 16) * DM + bj * 128)));
      }
      const unsigned ro = lo + (unsigned)((ai * 128 + m * 16) * DM);
#pragma unroll
      for (int bj = 0; bj < 2; ++bj) {
        const u32x4 xb = xv[gi & 1][bj];
        const f32x4 x0 = (f32x4){bf_lo(xb[0]), bf_hi(xb[0]), bf_lo(xb[1]), bf_hi(xb[1])}, x1 = (f32x4){bf_lo(xb[2]), bf_hi(xb[2]), bf_lo(xb[3]), bf_hi(xb[3])};
        const f32x4 v0 = x0 + g[bj][0] * acc[ai][bj][m][0], v1 = x1 + g[bj][1] * acc[ai][bj][m][1];
        *(u32x4*)(x2base + ro + bj * 128) = (u32x4){pack_bf16(v0[0], v0[1]), pack_bf16(v0[2], v0[3]), pack_bf16(v1[0], v1[1]), pack_bf16(v1[2], v1[3])};
      }
    }
  }
};
struct Epi8MlpIn {
  const Params& p;
  __device__ __forceinline__ void operator()(f32x4 (&acc)[2][2][4][2], int pm, int pn, int wr, int wc, int fr, int fq) const {
    bf16_t* hid = (bf16_t*)(p.ws + OFF_PROJ);
    const float* ssq = (const float*)(p.ws + OFF_SSQ);
    const int c0 = pn * 256 + wc * 32 + fq * 8;
    const float* b2 = (const float*)(p.ws + OFF_BIAS2) + row_batch(pm * 256) * DFF + c0;
    f32x4 bias[2][2];
#pragma unroll
    for (int bj = 0; bj < 2; ++bj)
#pragma unroll
      for (int n = 0; n < 2; ++n) bias[bj][n] = *(const f32x4*)(b2 + bj * 128 + n * 4);
    float rsv[8];
#pragma unroll
    for (int gi = 0; gi < 8; ++gi) rsv[gi] = ssq[pm * 256 + (gi >> 2) * 128 + wr * 64 + (gi & 3) * 16 + fr];
#pragma unroll
    for (int ai = 0; ai < 2; ++ai)
#pragma unroll
      for (int m = 0; m < 4; ++m) {
        const int R = pm * 256 + ai * 128 + wr * 64 + m * 16 + fr;
        const float rs = rsqrtf(rsv[ai * 4 + m] * (1.f / 1024.f) + 1e-6f);
        bf16_t* rowp = hid + (size_t)R * DFF + c0;
#pragma unroll
        for (int bj = 0; bj < 2; ++bj) {
          float v[8];
#pragma unroll
          for (int e = 0; e < 8; ++e) { const float t = fmaxf(acc[ai][bj][m][e >> 2][e & 3] * rs + bias[bj][e >> 2][e & 3], 0.f); v[e] = t * t; }
          __builtin_nontemporal_store((u32x4){pack_bf16(v[0], v[1]), pack_bf16(v[2], v[3]), pack_bf16(v[4], v[5]), pack_bf16(v[6], v[7])}, (u32x4*)(rowp + bj * 128));
        }
      }
  }
};

__device__ __forceinline__ int t_sw(int row) { return ((row & 3) << 2) | ((row >> 2) & 3); }
__device__ __forceinline__ int t_off(int row, int ch) { return 256 * row + 16 * (ch ^ t_sw(row)); }

__device__ __forceinline__ void tile_glds(lchar* dst, const bf16_t* src, size_t ld) {
  const int tid = threadIdx.x, wid = tid >> 6;
#pragma unroll
  for (int i = 0; i < 4; ++i) {
    const int L = i * 512 + tid, row = L >> 4, ch = (L & 15) ^ t_sw(row);
    __builtin_amdgcn_global_load_lds((const unsigned*)(src + (size_t)row * ld + ch * 8), (LAS unsigned*)(dst + (i * 512 + wid * 64) * 16), 16, 0, 0);
  }
}
__device__ __forceinline__ bf16x8 frag_row(const lchar* tile, int rbase, int ks, int fr, int fq) {
  return *(const LAS bf16x8*)(tile + t_off(rbase + fr, 4 * ks + fq));
}
__device__ __forceinline__ bf16x8 frag_tr(const lchar* tile, int c, int ks, int lane) {
  const int g = lane >> 4, q = (lane & 15) >> 2, pp = lane & 3;
  const int r0 = 32 * ks + 8 * g + q;
  s16x4 lo = __builtin_amdgcn_ds_read_tr16_b64_v4i16((LAS s16x4*)(tile + t_off(r0, 2 * c + (pp >> 1)) + 8 * (pp & 1)));
  s16x4 hi = __builtin_amdgcn_ds_read_tr16_b64_v4i16((LAS s16x4*)(tile + t_off(r0 + 4, 2 * c + (pp >> 1)) + 8 * (pp & 1)));
  return (bf16x8){lo[0], lo[1], lo[2], lo[3], hi[0], hi[1], hi[2], hi[3]};
}
template <bool ATR, bool BTR>
__device__ __forceinline__ void mm128(f32x4 (&acc)[2][4], const lchar* At, const lchar* Bt) {
  const int tid = threadIdx.x, wid = tid >> 6, lane = tid & 63, wr = wid >> 1, wc = wid & 1, fr = lane & 15, fq = lane >> 4;
  bf16x8 a[2][2], b[2][4];
#pragma unroll
  for (int m = 0; m < 2; ++m) a[0][m] = ATR ? frag_tr(At, wr * 2 + m, 0, lane) : frag_row(At, wr * 32 + m * 16, 0, fr, fq);
#pragma unroll
  for (int n = 0; n < 4; ++n) b[0][n] = BTR ? frag_tr(Bt, wc * 4 + n, 0, lane) : frag_row(Bt, wc * 64 + n * 16, 0, fr, fq);
#pragma unroll
  for (int ks = 0; ks < 4; ++ks) {
    const int c = ks & 1, d = c ^ 1;
    if (ks < 3) {
#pragma unroll
      for (int m = 0; m < 2; ++m) a[d][m] = ATR ? frag_tr(At, wr * 2 + m, ks + 1, lane) : frag_row(At, wr * 32 + m * 16, ks + 1, fr, fq);
#pragma unroll
      for (int n = 0; n < 4; ++n) b[d][n] = BTR ? frag_tr(Bt, wc * 4 + n, ks + 1, lane) : frag_row(Bt, wc * 64 + n * 16, ks + 1, fr, fq);
    }
#pragma unroll
    for (int m = 0; m < 2; ++m)
#pragma unroll
      for (int n = 0; n < 4; ++n) acc[m][n] = __builtin_amdgcn_mfma_f32_16x16x32_bf16(b[c][n], a[c][m], acc[m][n], 0, 0, 0);
    __builtin_amdgcn_sched_barrier(0);
  }
}
__device__ __forceinline__ void zero_acc(f32x4 (&acc)[2][4]) {
#pragma unroll
  for (int m = 0; m < 2; ++m)
#pragma unroll
    for (int n = 0; n < 4; ++n) acc[m][n] = (f32x4){0.f, 0.f, 0.f, 0.f};
}
__device__ __forceinline__ void acc_to_image(lchar* tile, const f32x4 (&acc)[2][4]) {
  const int tid = threadIdx.x, wid = tid >> 6, lane = tid & 63, wr = wid >> 1, wc = wid & 1, fr = lane & 15, fq = lane >> 4;
#pragma unroll
  for (int m = 0; m < 2; ++m)
#pragma unroll
    for (int n = 0; n < 4; ++n) {
      const int row = wr * 32 + m * 16 + fr, col = wc * 64 + n * 16 + fq * 4;
      *(LAS u32x2*)(tile + t_off(row, col >> 3) + (col & 7) * 2) = (u32x2){pack_bf16(acc[m][n][0], acc[m][n][1]), pack_bf16(acc[m][n][2], acc[m][n][3])};
    }
}

__device__ void transpose_item(const Params& p, lchar* shm, int t) {
  constexpr int T_IN = 16 * 10, T_OUT = 16 * 4, T_1 = 16 * 16;
  const int tid = threadIdx.x; char* ws = p.ws;
  const float* src; bf16_t* dst; int K, N, perm = 0;
  if (t < T_IN) { src = p.w_in; dst = (bf16_t*)(ws + OFF_WIN); K = 1024; N = INW; perm = 1; }
  else if ((t -= T_IN) < T_OUT) { src = p.w_out; dst = (bf16_t*)(ws + OFF_WOUT); K = 1024; N = 1024; perm = 2; }
  else if ((t -= T_OUT) < T_1) { src = p.w_mlp_in; dst = (bf16_t*)(ws + OFF_W1); K = 1024; N = DFF; perm = 2; }
  else { t -= T_1; src = p.w_mlp_out; dst = (bf16_t*)(ws + OFF_W2); K = DFF; N = 1024; perm = 2; }
  const int nNt = N / 256, k0 = (t / nNt) * 64, n0 = (t % nNt) * 256;
  LAS float* tl = (LAS float*)shm;
  f32x4 ld[8];
#pragma unroll
  for (int i = 0; i < 8; ++i) { const int kk = i * 8 + (tid >> 6), nn = (tid & 63) * 4; ld[i] = *(const f32x4*)(src + (size_t)(k0 + kk) * N + n0 + nn); }
#pragma unroll
  for (int i = 0; i < 8; ++i) { const int kk = i * 8 + (tid >> 6), nn = (tid & 63) * 4; tl[kk * 257 + nn] = ld[i][0]; tl[kk * 257 + nn + 1] = ld[i][1]; tl[kk * 257 + nn + 2] = ld[i][2]; tl[kk * 257 + nn + 3] = ld[i][3]; }
  __syncthreads();
#pragma unroll
  for (int q = 0; q < 4; ++q) {
    const int nn = q * 64 + (tid >> 3), kc = tid & 7;
    float v[8];
#pragma unroll
    for (int e = 0; e < 8; ++e) v[e] = tl[(kc * 8 + e) * 257 + nn];
    int nrow = n0 + nn;
    if (perm) {
      const int a = nrow & 255, ag = a >> 5, w = a & 31;
      const int rho = 16 * ((w >> 2) & 1) + 4 * (w >> 3) + (w & 3);
      const int gi = (perm == 1) ? (((ag >> 1) & 1) * 4 + (ag >> 2) * 2 + (ag & 1)) : ag;
      nrow = (nrow & ~255) + gi * 32 + rho;
    }
    *(u32x4*)(dst + (size_t)nrow * K + k0 + kc * 8) = (u32x4){pack_bf16(v[0], v[1]), pack_bf16(v[2], v[3]), pack_bf16(v[4], v[5]), pack_bf16(v[6], v[7])};
  }
  __syncthreads();
}
__device__ void late_transposes(const Params& p, lchar* shm) {
  const int half = gridDim.x >> 1;
  if ((int)blockIdx.x >= half) for (int t = 160 + (int)blockIdx.x - half; t < 160 + 576; t += (int)gridDim.x - half) transpose_item(p, shm, t);
}

__device__ void phase0a(const Params& p, lchar* shm) {
  const int tid = threadIdx.x, wid = tid >> 6, lane = tid & 63;
  const int gtid = (gridDim.x - 1 - blockIdx.x) * 512 + tid, gsz = gridDim.x * 512;
  char* ws = p.ws;
  {
    float2* rot = (float2*)(ws + OFF_ROT);
    bf16_t* ft = (bf16_t*)(ws + OFF_FTAB);
    float2* twp = (float2*)(ws + OFF_TWP);
    float2* tws = (float2*)(ws + OFF_TWS);
    float* gp = (float*)(ws + OFF_GPOW);
    constexpr int T0 = 16384, T1 = T0 + 5 * 16384, T2 = T1 + 16384, T3 = T2 + 2048, T4 = T3 + 2 * 4 * 132, T5 = T4 + NTOK;
    const int nthr = gsz > 160 * 512 ? 160 * 512 : gsz;
    if (gtid < nthr) for (int w = gtid; w < T5; w += nthr) {
      if (w < T0) {
        const int idx = w, which = idx >> 13, e = idx & 8191, a = e >> 6, j = e & 63;
        double inv = 1.0; for (int t = 0; t < j; ++t) inv *= 0.8659643233600653;
        const double ang = (which ? (double)a : 128.0 * (double)a) * inv;
        double s_, c_; sincos_d(ang, s_, c_);
        rot[idx] = make_float2((float)c_, (float)s_);
      } else if (w < T1) {
        const int idx = w - T0, t = idx >> 14, e = idx & 16383, row = e >> 7, col = e & 127;
        double s_, c_; float v;
        if (t < 3) { sincos_d(6.283185307179586476925 * (double)((row * col) & 127) / 128.0, s_, c_); v = (t == 0) ? (float)c_ : (t == 1 ? (float)(-s_) : (float)s_); }
        else { sincos_d(6.283185307179586476925 * (double)(((row & 15) * (col & 15)) & 15) / 16.0, s_, c_); v = ((row >> 4) == (col >> 4)) ? (t == 3 ? (float)c_ : (float)s_) : 0.f; }
        ft[idx] = (bf16_t)(pack_bf16(v, 0.f) & 0xffff);
      } else if (w < T2) {
        const int idx = w - T1; double s_, c_; sincos_d(6.283185307179586476925 * (double)idx / 16384.0, s_, c_);
        const double nrm = 1.0 / sqrt(16384.0 * 128.0);
        twp[idx] = make_float2((float)(c_ * nrm), (float)(-s_ * nrm));
      } else if (w < T3) {
        const int idx = w - T2; double s_, c_; sincos_d(6.283185307179586476925 * (double)idx / 2048.0, s_, c_);
        tws[idx] = make_float2((float)(c_ / 512.0), (float)(-s_ / 512.0));
      } else if (w < T4) {
        const int idx = w - T3, dir = idx / (4 * 132), h = (idx / 132) & 3, t = idx % 132;
        double e2 = 1.0 / 32.0; for (int i = 0; i < h; ++i) e2 *= 0.5;
        if (dir) e2 *= 0.70710678118654752440;
        const double g = 1.0 - e2; double v = 1.0; for (int i = 0; i < t; ++i) v *= g;
        gp[idx] = (float)v;
      } else {
        ((float*)(ws + OFF_SSQ))[w - T4] = 0.f;
      }
    }
  }
  {
    LAS f32x2* ctab = (LAS f32x2*)shm;
    if (tid < 128) { double s, c; sincos_d(6.283185307179586476925 * (double)tid / 128.0, s, c); ctab[tid] = (f32x2){(float)c, (float)s}; }
    __syncthreads();
    bf16_t* mt = (bf16_t*)(ws + OFF_MTAB);
    for (int idx = gtid; idx < 65536; idx += gsz) {
      const int g = idx >> 14, c = (idx >> 7) & 127, d = idx & 127;
      const float* W = p.w_fnet + (size_t)g * 16384 + d;
      float mr = 0.f, mi = 0.f;
#pragma unroll 32
      for (int cc = 0; cc < 128; ++cc) { const float w = W[cc * 128]; const f32x2 t = ctab[(c * cc) & 127]; mr += t.x * w; mi -= t.y * w; }
      const int drow = (d & ~31) + invperm32(invperm32(d & 31));
      mt[(size_t)(g * 2 + 0) * 16384 + drow * 128 + c] = (bf16_t)(pack_bf16(mr, 0.f) & 0xffff);
      mt[(size_t)(g * 2 + 1) * 16384 + drow * 128 + c] = (bf16_t)(pack_bf16(mi, 0.f) & 0xffff);
    }
    __syncthreads();
  }
  constexpr int N_GEMV = 96, T_IN = 16 * 10;
  for (int item = blockIdx.x; item < N_GEMV + T_IN; item += gridDim.x) {
    if (item < N_GEMV) {
      LAS float* sc = (LAS float*)shm;
      LAS float* red = (LAS float*)(shm + 49152);
      for (int i = tid; i < NB * 1024; i += 512) { const int b = i >> 10, k = i & 1023; const float v = b < 2 ? p.c_prompt[b * 1024 + k] : p.c_sample[(b - 2) * 1024 + k]; sc[k * 12 + b] = silu_f(v); }
      __syncthreads();
      const int col = item * 64 + lane;
      float a[NB];
#pragma unroll
      for (int b = 0; b < NB; ++b) a[b] = 0.f;
      for (int k0 = wid * 128; k0 < wid * 128 + 128; k0 += 32) {
        float w[32];
#pragma unroll
        for (int u = 0; u < 32; ++u) w[u] = p.ada_w[(size_t)(k0 + u) * 6144 + col];
#pragma unroll
        for (int u = 0; u < 32; ++u) {
          const f32x4 s0 = *(const LAS f32x4*)(sc + (k0 + u) * 12), s1 = *(const LAS f32x4*)(sc + (k0 + u) * 12 + 4), s2 = *(const LAS f32x4*)(sc + (k0 + u) * 12 + 8);
          a[0] += s0[0] * w[u]; a[1] += s0[1] * w[u]; a[2] += s0[2] * w[u]; a[3] += s0[3] * w[u];
          a[4] += s1[0] * w[u]; a[5] += s1[1] * w[u]; a[6] += s1[2] * w[u]; a[7] += s1[3] * w[u];
          a[8] += s2[0] * w[u]; a[9] += s2[1] * w[u];
        }
      }
#pragma unroll
      for (int b = 0; b < NB; ++b) red[(wid * NB + b) * 64 + lane] = a[b];
      __syncthreads();
      for (int i = tid; i < NB * 64; i += 512) {
        const int b = i >> 6, l = i & 63; float s = p.ada_b[item * 64 + l];
        for (int w = 0; w < 8; ++w) s += red[(w * NB + b) * 64 + l];
        ((float*)(ws + OFF_MOD))[b * 6144 + item * 64 + l] = s;
      }
      __syncthreads();
    } else {
      transpose_item(p, shm, item - N_GEMV);
    }
  }
}

__device__ void bias2_items(const Params& p, lchar* shm) {
  const int tid = threadIdx.x, wid = tid >> 6, lane = tid & 63;
  const float* mod = (const float*)(p.ws + OFF_MOD);
  const int first = (int)gridDim.x > 64 ? (int)gridDim.x - 64 : 0;
  for (int item = (int)blockIdx.x - first; item >= 0 && item < 64; item += (int)gridDim.x - first) {
    LAS float* sc = (LAS float*)shm;
    LAS float* red = (LAS float*)(shm + 40960);
    for (int i = tid; i < NB * 1024; i += 512) sc[i] = mod[(i >> 10) * 6144 + 3072 + (i & 1023)];
    __syncthreads();
    const int col = item * 64 + lane;
    float a[NB];
#pragma unroll
    for (int b = 0; b < NB; ++b) a[b] = 0.f;
    for (int k = wid * 128; k < wid * 128 + 128; ++k) {
      const float w = p.w_mlp_in[(size_t)k * DFF + col];
#pragma unroll
      for (int b = 0; b < NB; ++b) a[b] += sc[b * 1024 + k] * w;
    }
#pragma unroll
    for (int b = 0; b < NB; ++b) red[(wid * NB + b) * 64 + lane] = a[b];
    __syncthreads();
    for (int i = tid; i < NB * 64; i += 512) {
      const int b = i >> 6, l = i & 63; float sum = 0.f;
      for (int w = 0; w < 8; ++w) sum += red[(w * NB + b) * 64 + l];
      ((float*)(p.ws + OFF_BIAS2))[b * DFF + item * 64 + l] = sum;
    }
    __syncthreads();
  }
}

__device__ __forceinline__ void row_finish(const Params& p, int which, int R, const f32x4 (&v)[4], int lane, const f32x4 (&gq)[4]) {
  const float* mod = (const float*)(p.ws + OFF_MOD);
  float ss = 0.f;
#pragma unroll
  for (int i = 0; i < 4; ++i) ss += v[i][0] * v[i][0] + v[i][1] * v[i][1] + v[i][2] * v[i][2] + v[i][3] * v[i][3];
#pragma unroll
  for (int o = 32; o > 0; o >>= 1) ss += __shfl_xor(ss, o);
  const float rs = rsqrtf(ss * (1.f / 1024.f) + 1e-6f);
  if (which == 2) {
#pragma unroll
    for (int i = 0; i < 4; ++i) __builtin_nontemporal_store(v[i] * rs * gq[i], (f32x4*)(p.out + (size_t)R * DM + i * 256 + lane * 4));
  } else {
    const float* md = mod + row_batch(R) * 6144 + (which ? 3072 : 0);
    bf16_t* dst = which ? (bf16_t*)(p.ws + OFF_H2) : (bf16_t*)((char*)p.out + OUT_H);
#pragma unroll
    for (int i = 0; i < 4; ++i) {
      const int col = i * 256 + lane * 4;
      const f32x4 sh = *(const f32x4*)(md + col), sc = *(const f32x4*)(md + 1024 + col);
      const f32x4 y = v[i] * rs * gq[i] * (sc + 1.f) + sh;
      *(u32x2*)(dst + (size_t)R * DM + col) = (u32x2){pack_bf16(y[0], y[1]), pack_bf16(y[2], y[3])};
    }
  }
}
__device__ void rows_phase(const Params& p, int which) {
  const int tid = threadIdx.x, lane = tid & 63;
  const int stride = gridDim.x * 8;
  f32x4 gq[4];
  { const float* gsrc = (which == 2) ? p.norm_final : (which ? p.norm_mlp : p.norm_mix);
#pragma unroll
    for (int i = 0; i < 4; ++i) gq[i] = *(const f32x4*)(gsrc + i * 256 + lane * 4); }
  for (int R0 = blockIdx.x * 8 + (tid >> 6); R0 < NTOK; R0 += 2 * stride) {
    const int Ra = (which == 2) ? NTOK - 1 - R0 : R0;
    const int R1 = R0 + stride; const bool two = R1 < NTOK;
    const int Rb = (which == 2) ? NTOK - 1 - R1 : R1;
    f32x4 va[4], vb[4];
    if (which == 2) {
      const bf16_t* x2 = (const bf16_t*)(p.ws + OFF_H2);
      u32x2 ua[4], ub[4];
#pragma unroll
      for (int i = 0; i < 4; ++i) ua[i] = __builtin_nontemporal_load((const u32x2*)(x2 + (size_t)Ra * DM + i * 256 + lane * 4));
#pragma unroll
      for (int i = 0; i < 4; ++i) ub[i] = __builtin_nontemporal_load((const u32x2*)(x2 + (size_t)(two ? Rb : Ra) * DM + i * 256 + lane * 4));
#pragma unroll
      for (int i = 0; i < 4; ++i) { va[i] = (f32x4){bf_lo(ua[i][0]), bf_hi(ua[i][0]), bf_lo(ua[i][1]), bf_hi(ua[i][1])}; vb[i] = (f32x4){bf_lo(ub[i][0]), bf_hi(ub[i][0]), bf_lo(ub[i][1]), bf_hi(ub[i][1])}; }
    } else {
      const float* sa = which ? p.out + (size_t)Ra * DM : xrow(p, Ra);
      const float* sb = two ? (which ? p.out + (size_t)Rb * DM : xrow(p, Rb)) : sa;
#pragma unroll
      for (int i = 0; i < 4; ++i) va[i] = __builtin_nontemporal_load((const f32x4*)(sa + i * 256 + lane * 4));
#pragma unroll
      for (int i = 0; i < 4; ++i) vb[i] = __builtin_nontemporal_load((const f32x4*)(sb + i * 256 + lane * 4));
    }
    row_finish(p, which, Ra, va, lane, gq);
    if (two) row_finish(p, which, Rb, vb, lane, gq);
  }
}

__device__ __forceinline__ void tile_load_regs(u32x4 (&v)[4], const bf16_t* src, size_t ld) {
  const int tid = threadIdx.x;
#pragma unroll
  for (int i = 0; i < 4; ++i) { const int L = i * 512 + tid, row = L >> 4, ch = L & 15; v[i] = *(const u32x4*)(src + (size_t)row * ld + ch * 8); }
}
__device__ __forceinline__ void tile_load_regs_nt(u32x4 (&v)[4], const bf16_t* src, size_t ld) {
  const int tid = threadIdx.x;
#pragma unroll
  for (int i = 0; i < 4; ++i) { const int L = i * 512 + tid, row = L >> 4, ch = L & 15; v[i] = __builtin_nontemporal_load((const u32x4*)(src + (size_t)row * ld + ch * 8)); }
}
__device__ __forceinline__ void tile_store_regs(lchar* dst, const u32x4 (&v)[4]) {
  const int tid = threadIdx.x;
#pragma unroll
  for (int i = 0; i < 4; ++i) { const int L = i * 512 + tid, row = L >> 4, ch = L & 15; *(LAS u32x4*)(dst + t_off(row, ch)) = v[i]; }
}
__device__ __forceinline__ void load_afrags(bf16x8 (&a)[2][4], const bf16_t* tab) {
  const int tid = threadIdx.x, wid = tid >> 6, lane = tid & 63, wr = wid >> 1, fr = lane & 15, fq = lane >> 4;
#pragma unroll
  for (int m = 0; m < 2; ++m)
#pragma unroll
    for (int ks = 0; ks < 4; ++ks) a[m][ks] = *(const bf16x8*)(tab + (wr * 32 + m * 16 + fr) * 128 + ks * 32 + fq * 8);
}
template <bool BTR>
__device__ __forceinline__ void mm128_areg(f32x4 (&acc)[2][4], const bf16x8 (&a)[2][4], const lchar* Bt) {
  const int tid = threadIdx.x, wid = tid >> 6, lane = tid & 63, wc = wid & 1, fr = lane & 15, fq = lane >> 4;
  bf16x8 b[2][4];
#pragma unroll
  for (int n = 0; n < 4; ++n) b[0][n] = BTR ? frag_tr(Bt, wc * 4 + n, 0, lane) : frag_row(Bt, wc * 64 + n * 16, 0, fr, fq);
#pragma unroll
  for (int ks = 0; ks < 4; ++ks) {
    const int c = ks & 1, d = c ^ 1;
    if (ks < 3) {
#pragma unroll
      for (int n = 0; n < 4; ++n) b[d][n] = BTR ? frag_tr(Bt, wc * 4 + n, ks + 1, lane) : frag_row(Bt, wc * 64 + n * 16, ks + 1, fr, fq);
    }
#pragma unroll
    for (int m = 0; m < 2; ++m)
#pragma unroll
      for (int n = 0; n < 4; ++n) acc[m][n] = __builtin_amdgcn_mfma_f32_16x16x32_bf16(b[c][n], a[m][ks], acc[m][n], 0, 0, 0);
    __builtin_amdgcn_sched_barrier(0);
  }
}

struct FftAItem { const bf16_t* src; size_t ld; const float2* tw; size_t tbase; int s2, ns2; };
__device__ __forceinline__ FftAItem ffta_item(const Params& p, int g, int j) {
  FftAItem it; const bf16_t* proj = (const bf16_t*)(p.ws + OFF_PROJ);
  if (j < 256) { const int b = j >> 7; it.s2 = j & 127; it.ns2 = 128; it.src = proj + (size_t)(b * 16384 + it.s2) * INW + g * 128; it.ld = (size_t)128 * INW;
    it.tw = (const float2*)(p.ws + OFF_TWP); it.tbase = (size_t)(b * 4 + g) * 128 * 128 * 128; }
  else { const int jj = j - 256, b = jj >> 4; it.s2 = jj & 15; it.ns2 = 16; it.src = proj + (size_t)(PROWS + b * 2048 + it.s2) * INW + g * 128; it.ld = (size_t)16 * INW;
    it.tw = (const float2*)(p.ws + OFF_TWS); it.tbase = (size_t)16777216 + (size_t)(b * 4 + g) * 128 * 16 * 128; }
  return it;
}
__device__ void phase2(const Params& p, lchar* shm) {
  const int tid = threadIdx.x, wid = tid >> 6, lane = tid & 63, wr = wid >> 1, wc = wid & 1, fr = lane & 15, fq = lane >> 4;
  lchar *R0 = shm, *R1 = shm + 32768, *R2 = shm + 65536, *R3 = shm + 98304;
  const bf16_t* proj = (const bf16_t*)(p.ws + OFF_PROJ);
  const bf16_t* ft = (const bf16_t*)(p.ws + OFF_FTAB);
  const bf16_t* mt = (const bf16_t*)(p.ws + OFF_MTAB);
  bf16_t* tre = (bf16_t*)((char*)p.out + OUT_H);
  bf16_t* tim = tre + (size_t)NTOK * 512;
  const float* gp = (const float*)(p.ws + OFF_GPOW);
  {
    const int g = blockIdx.x & 3, nper = gridDim.x >> 2, slot = blockIdx.x >> 2;
    if (slot < nper) {
      tile_glds(R2, mt + (size_t)(g * 2) * 16384, 128);
      tile_glds(R3, mt + (size_t)(g * 2 + 1) * 16384, 128);
      bf16x8 far[2][4], fai[2][4];
      load_afrags(far, ft); load_afrags(fai, ft + 16384);
      u32x4 xr[4];
      int j = slot;
      if (j < 384) { const FftAItem it = ffta_item(p, g, j); tile_load_regs_nt(xr, it.src, it.ld); }
      WAIT_V0(); __syncthreads();
      for (; j < 384; j += nper) {
        const FftAItem it = ffta_item(p, g, j);
        tile_store_regs(R0, xr);
        __syncthreads();
        if (j + nper < 384) { const FftAItem nx = ffta_item(p, g, j + nper); tile_load_regs_nt(xr, nx.src, nx.ld); }
        float2 twv[2];
#pragma unroll
        for (int m = 0; m < 2; ++m) twv[m] = it.tw[it.s2 * (wr * 32 + m * 16 + fr)];
        f32x4 ar[2][4], ai[2][4];
        zero_acc(ar); zero_acc(ai);
        mm128_areg<true>(ar, far, R0);
        mm128_areg<true>(ai, fai, R0);
#pragma unroll
        for (int m = 0; m < 2; ++m) {
          const float2 w = twv[m];
#pragma unroll
          for (int n = 0; n < 4; ++n)
#pragma unroll
            for (int r = 0; r < 4; ++r) { const float a = ar[m][n][r], bb = ai[m][n][r]; ar[m][n][r] = a * w.x - bb * w.y; ai[m][n][r] = a * w.y + bb * w.x; }
        }
        __syncthreads();
        acc_to_image(R0, ar); acc_to_image(R1, ai);
        __syncthreads();
        zero_acc(ar); zero_acc(ai);
        mm128<false, false>(ar, R0, R2);
        mm128<false, false>(ai, R1, R3);
#pragma unroll
        for (int m = 0; m < 2; ++m) {
          const int k1 = wr * 32 + m * 16 + fr;
          const size_t rb = it.tbase + ((size_t)k1 * it.ns2 + it.s2) * 128 + wc * 64 + fq * 8;
#pragma unroll
          for (int n2 = 0; n2 < 2; ++n2) {
            const f32x4 r0 = ar[m][2 * n2] - ai[m][2 * n2], r1 = ar[m][2 * n2 + 1] - ai[m][2 * n2 + 1];
            *(u32x4*)(tre + rb + n2 * 32) = (u32x4){pack_bf16(r0[0], r0[1]), pack_bf16(r0[2], r0[3]), pack_bf16(r1[0], r1[1]), pack_bf16(r1[2], r1[3])};
          }
        }
        zero_acc(ar);
        mm128<false, false>(ar, R0, R3);
        mm128<false, false>(ar, R1, R2);
#pragma unroll
        for (int m = 0; m < 2; ++m) {
          const int k1 = wr * 32 + m * 16 + fr;
          const size_t rb = it.tbase + ((size_t)k1 * it.ns2 + it.s2) * 128 + wc * 64 + fq * 8;
#pragma unroll
          for (int n2 = 0; n2 < 2; ++n2)
            *(u32x4*)(tim + rb + n2 * 32) = (u32x4){pack_bf16(ar[m][2 * n2][0], ar[m][2 * n2][1]), pack_bf16(ar[m][2 * n2][2], ar[m][2 * n2][3]), pack_bf16(ar[m][2 * n2 + 1][0], ar[m][2 * n2 + 1][1]), pack_bf16(ar[m][2 * n2 + 1][2], ar[m][2 * n2 + 1][3])};
        }
        __syncthreads();
      }
    }
  }
  {
    u32x4 kr[4], vr[4];
    float zfv[4], zbv[4];
    int it = blockIdx.x;
    if (it < 1536) { const bf16_t* kp = proj + (size_t)(it >> 2) * 128 * INW + 1024 + (it & 3) * 128; tile_load_regs_nt(kr, kp, INW); tile_load_regs_nt(vr, kp + 512, INW);
#pragma unroll
      for (int i = 0; i < 4; ++i) { const int row = (i * 512 + tid) >> 4; zfv[i] = gp[(it & 3) * 132 + 127 - row]; zbv[i] = gp[(4 + (it & 3)) * 132 + row]; } }
    for (; it < 1536; it += gridDim.x) {
      const int cidx = it >> 2, h = it & 3;
      tile_store_regs(R0, kr);
#pragma unroll
      for (int i = 0; i < 4; ++i) {
        const int L = i * 512 + tid, row = L >> 4, ch = L & 15;
        const float zf = zfv[i], zb = zbv[i];
        u32x4 of, ob;
#pragma unroll
        for (int e = 0; e < 4; ++e) { const float lo = bf_lo(vr[i][e]), hi = bf_hi(vr[i][e]); of[e] = pack_bf16(lo * zf, hi * zf); ob[e] = pack_bf16(lo * zb, hi * zb); }
        *(LAS u32x4*)(R1 + t_off(row, ch)) = of;
        *(LAS u32x4*)(R2 + t_off(row, ch)) = ob;
      }
      __syncthreads();
      if (it + (int)gridDim.x < 1536) { const int nx = it + gridDim.x; const bf16_t* kp = proj + (size_t)(nx >> 2) * 128 * INW + 1024 + (nx & 3) * 128; tile_load_regs_nt(kr, kp, INW); tile_load_regs_nt(vr, kp + 512, INW);
#pragma unroll
        for (int i = 0; i < 4; ++i) { const int row = (i * 512 + tid) >> 4; zfv[i] = gp[(nx & 3) * 132 + 127 - row]; zbv[i] = gp[(4 + (nx & 3)) * 132 + row]; } }
      f32x4 kf[2][4], kb[2][4];
      zero_acc(kf); zero_acc(kb);
      mm128<true, true>(kf, R0, R1);
      mm128<true, true>(kb, R0, R2);
      bf16_t* kvf = (bf16_t*)((char*)p.out + OUT_KV) + (size_t)(cidx * 4 + h) * 16384;
      bf16_t* kvb = kvf + (size_t)1536 * 16384;
#pragma unroll
      for (int m = 0; m < 2; ++m) {
        const int d = wr * 32 + m * 16 + fr;
#pragma unroll
        for (int n = 0; n < 4; ++n) {
          const int e = wc * 64 + n * 16 + fq * 4;
          *(u32x2*)(kvf + d * 128 + e) = (u32x2){pack_bf16(kf[m][n][0], kf[m][n][1]), pack_bf16(kf[m][n][2], kf[m][n][3])};
          *(u32x2*)(kvb + d * 128 + e) = (u32x2){pack_bf16(kb[m][n][0], kb[m][n][1]), pack_bf16(kb[m][n][2], kb[m][n][3])};
        }
      }
      __syncthreads();
    }
  }
}

__device__ void phase3(const Params& p, lchar* shm) {
  const int tid = threadIdx.x, wid = tid >> 6, lane = tid & 63, wr = wid >> 1, wc = wid & 1, fr = lane & 15, fq = lane >> 4;
  lchar *R0 = shm, *R1 = shm + 32768, *R2 = shm + 65536, *R3 = shm + 98304;
  bf16_t* proj = (bf16_t*)(p.ws + OFF_PROJ);
  const bf16_t* ft = (const bf16_t*)(p.ws + OFF_FTAB);
  const bf16_t* tre = (const bf16_t*)((char*)p.out + OUT_H);
  const bf16_t* tim = tre + (size_t)NTOK * 512;
  const float* gp = (const float*)(p.ws + OFF_GPOW);
  {
    const unsigned* kv = (const unsigned*)((char*)p.out + OUT_KV);
    unsigned* pv = (unsigned*)(p.ws + OFF_PREV);
    const int gtid = blockIdx.x * 512 + tid, gsz = gridDim.x * 512;
#if DBG == 17
    for (int rep = 0; rep < 2; ++rep)
#endif
    for (int w = gtid; w < 16 * 8192 + 64 * 8192; w += gsz) {
      int dir, h, c0, nch;
      const int pr = w & 8191;
      if (w < 16 * 8192) { const int ch = w >> 13; dir = ch >> 3; const int b = (ch >> 2) & 1; h = ch & 3; c0 = b * 128; nch = 128; }
      else { const int ch = (w >> 13) - 16; dir = ch >> 5; const int b = (ch >> 2) & 7; h = ch & 3; c0 = 256 + b * 16; nch = 16; }
      const float g = gp[(dir * 4 + h) * 132 + 128];
      const size_t boff = (size_t)dir * 1536 * 8192 + (size_t)h * 8192 + pr;
      const unsigned* base = kv + boff; unsigned* obase = pv + boff;
      float s0 = 0.f, s1 = 0.f;
      for (int n8 = 0; n8 < nch; n8 += 16) {
        unsigned t[16];
#pragma unroll
        for (int j = 0; j < 16; ++j) { const int n = dir ? (nch - 1 - (n8 + j)) : (n8 + j); t[j] = __builtin_nontemporal_load(base + (size_t)(c0 + n) * 4 * 8192); }
#pragma unroll
        for (int j = 0; j < 16; ++j) {
          const int n = dir ? (nch - 1 - (n8 + j)) : (n8 + j);
          obase[(size_t)(c0 + n) * 4 * 8192] = pack_bf16(s0, s1);
          s0 = s0 * g + bf_lo(t[j]); s1 = s1 * g + bf_hi(t[j]);
        }
      }
    }
  }
  {
    auto tb_of = [&](int item) -> size_t {
      if (item < 1024) { const int b = item >> 9, g = (item >> 7) & 3, k1 = item & 127; return ((size_t)(b * 4 + g) * 128 + k1) * 16384; }
      const int j = item - 1024, b = j >> 6, g = (j >> 4) & 3, kg = j & 15; return (size_t)16777216 + ((size_t)(b * 4 + g) * 128 + kg * 8) * 2048;
    };
    bf16x8 fa[2][4], fs[2][4];
    u32x4 tr[4], ti[4];
    int cur_tabs = -1;
    int item = blockIdx.x;
    if (item < 1536) { const size_t tb = tb_of(item); tile_load_regs_nt(tr, tre + tb, 128); tile_load_regs_nt(ti, tim + tb, 128); }
    for (; item < 1536; item += gridDim.x) {
      const int tabs = item < 1024 ? 0 : 1;
      if (tabs != cur_tabs) { load_afrags(fa, ft + (tabs ? 3 * 16384 : 0)); load_afrags(fs, ft + (tabs ? 4 * 16384 : 2 * 16384)); cur_tabs = tabs; }
      tile_store_regs(R0, tr); tile_store_regs(R1, ti);
      __syncthreads();
      if (item + (int)gridDim.x < 1536) { const size_t tb = tb_of(item + gridDim.x); tile_load_regs_nt(tr, tre + tb, 128); tile_load_regs_nt(ti, tim + tb, 128); }
      f32x4 y[2][4];
      zero_acc(y);
      mm128_areg<true>(y, fa, R0);
      mm128_areg<true>(y, fs, R1);
      int b, g, k1;
      if (item < 1024) { b = item >> 9; g = (item >> 7) & 3; k1 = item & 127; }
      else { const int j = item - 1024; b = j >> 6; g = (j >> 4) & 3; k1 = j & 15; }
#pragma unroll
      for (int m = 0; m < 2; ++m) {
        const int o = wr * 32 + m * 16 + fr;
        const int R = tabs ? (PROWS + b * 2048 + (k1 * 8 + (o >> 4)) + 128 * (o & 15)) : (b * 16384 + k1 + 128 * o);
        bf16_t* rowp = proj + (size_t)R * INW + g * 128 + wc * 64 + fq * 8;
#pragma unroll
        for (int n2 = 0; n2 < 2; ++n2)
          *(u32x4*)(rowp + n2 * 32) = (u32x4){pack_bf16(y[m][2 * n2][0], y[m][2 * n2][1]), pack_bf16(y[m][2 * n2][2], y[m][2 * n2][3]), pack_bf16(y[m][2 * n2 + 1][0], y[m][2 * n2 + 1][1]), pack_bf16(y[m][2 * n2 + 1][2], y[m][2 * n2 + 1][3])};
      }
      __syncthreads();
    }
  }
}

__device__ void phase4(const Params& p, lchar* shm, bool dummy = false) {
  const int tid = threadIdx.x, wid = tid >> 6, lane = tid & 63, wr = wid >> 1, wc = wid & 1, fr = lane & 15, fq = lane >> 4;
  lchar *R0 = shm, *R1 = shm + 32768, *R2 = shm + 65536, *R3 = shm + 98304;
  LAS float* xt = (LAS float*)(shm + 131072);
  LAS float* red = xt + 264;
  bf16_t* proj = (bf16_t*)(p.ws + OFF_PROJ);
  const float* gp = (const float*)(p.ws + OFF_GPOW);
  const bf16_t* kvall = (const bf16_t*)(p.ws + OFF_PREV);
  for (int item = blockIdx.x; item < 1536; item += gridDim.x) {
    const int cidx = item >> 2, h = item & 3;
    bf16_t* base = proj + (size_t)cidx * 128 * INW + h * 128;
    tile_glds(R0, base + 512, INW);
    tile_glds(R1, base + 1024, INW);
    tile_glds(R2, base + 1536, INW);
    tile_glds(R3, kvall + (size_t)(cidx * 4 + h) * 16384, 128);
    if (tid < 264) xt[tid] = gp[(tid < 132 ? h : 4 + h) * 132 + (tid < 132 ? tid : tid - 132)];
    WAIT_V0(); __syncthreads();
    f32x4 s[2][4], o[2][4];
    zero_acc(s); zero_acc(o);
    mm128<false, false>(s, R0, R1);
    mm128<false, true>(o, R0, R3);
    __syncthreads();
    tile_glds(R3, kvall + (size_t)(1536 + cidx * 4 + h) * 16384, 128);
#pragma unroll
    for (int m = 0; m < 2; ++m) {
      const int i = wr * 32 + m * 16 + fr;
      const float ratio = xt[i + 1] / xt[132 + 128 - i];
#pragma unroll
      for (int n = 0; n < 4; ++n)
#pragma unroll
        for (int r = 0; r < 4; ++r) {
          const int j = wc * 64 + n * 16 + fq * 4 + r, dd = i - j;
          s[m][n][r] *= (dd >= 0) ? xt[dd] : xt[132 - dd];
          o[m][n][r] *= ratio;
        }
    }
    acc_to_image(R1, s);
    u32x4 gw[4];
#pragma unroll
    for (int i = 0; i < 4; ++i) { const int L = i * 512 + tid; gw[i] = __builtin_nontemporal_load((const u32x4*)(base + (size_t)(L >> 4) * INW + 2048 + (L & 15) * 8)); }
    WAIT_V0(); __syncthreads();
    mm128<false, true>(o, R0, R3);
#pragma unroll
    for (int m = 0; m < 2; ++m) {
      const float xb = xt[132 + 128 - (wr * 32 + m * 16 + fr)];
#pragma unroll
      for (int n = 0; n < 4; ++n) o[m][n] *= xb;
    }
    mm128<false, true>(o, R1, R2);
    float ss[2];
#pragma unroll
    for (int m = 0; m < 2; ++m) {
      float a = 0.f;
#pragma unroll
      for (int n = 0; n < 4; ++n) a += o[m][n][0] * o[m][n][0] + o[m][n][1] * o[m][n][1] + o[m][n][2] * o[m][n][2] + o[m][n][3] * o[m][n][3];
      a += __shfl_xor(a, 16); a += __shfl_xor(a, 32);
      ss[m] = a;
      if (fq == 0) red[wc * 128 + wr * 32 + m * 16 + fr] = a;
    }
    __syncthreads();
#pragma unroll
    for (int m = 0; m < 2; ++m) {
      const int i = wr * 32 + m * 16 + fr;
      const float tot = red[i] + red[128 + i];
      const float rinv = rsqrtf(tot * (1.f / 128.f) + 1e-6f);
#pragma unroll
      for (int n = 0; n < 4; ++n) o[m][n] *= rinv;
    }
    (void)ss;
    acc_to_image(R0, o);
    __syncthreads();
#pragma unroll
    for (int i = 0; i < 4; ++i) {
      const int L = i * 512 + tid, row = L >> 4, ch = L & 15;
      const u32x4 rv = *(const LAS u32x4*)(R0 + t_off(row, ch));
      u32x4 ov;
#pragma unroll
      for (int e = 0; e < 4; ++e) ov[e] = pack_bf16(bf_lo(rv[e]) * bf_lo(gw[i][e]), bf_hi(rv[e]) * bf_hi(gw[i][e]));
      *(u32x4*)(base + (size_t)row * INW + 2048 + ch * 8) = ov;
    }
    __syncthreads();
  }
}

#define XB_TMO      128
#define XB_XCNT(j)  (256  + 64 * (j))
#define XB_XSUB(j)  (1280 + 64 * (j))
#define XB_XGEN(j)  (2304 + 64 * (j))
#define XB_TOP      3328
#define XB_TOPGEN   3392
#define XCD_BAR_WORDS 3456
#define XB_SPIN_CAP (1u << 18)
__device__ __forceinline__ unsigned xb_ld(unsigned* p)              { return __hip_atomic_load(p, __ATOMIC_RELAXED, __HIP_MEMORY_SCOPE_AGENT); }
__device__ __forceinline__ unsigned xb_add(unsigned* p, unsigned v) { return __hip_atomic_fetch_add(p, v, __ATOMIC_RELAXED, __HIP_MEMORY_SCOPE_AGENT); }
__device__ __forceinline__ unsigned xb_xcc_id() { return (unsigned)__builtin_amdgcn_s_getreg((3 << 11) | 20) & 0xFu; }
#define XB_SPIN(cond, bar) do { unsigned _sp = 0; while (cond) { __builtin_amdgcn_s_sleep(1); \
    if ((++_sp & 255u) == 0u) { if (xb_ld(&(bar)[XB_TMO])) break; if (_sp > XB_SPIN_CAP) { atomicAdd(&(bar)[XB_TMO], 1u); break; } } } } while (0)
struct XcdBarrier { unsigned* bar; unsigned x; volatile LAS unsigned* st; };
__device__ __forceinline__ XcdBarrier xcd_barrier_post(unsigned* bar, volatile LAS unsigned* st) {
  XcdBarrier b; b.bar = bar; b.x = xb_xcc_id(); b.st = st;
  if (threadIdx.x == 0) (void)xb_add(&bar[XB_XCNT(b.x)], 1u);
  return b;
}
__device__ __forceinline__ void xcd_barrier_complete(unsigned* bar, unsigned x, unsigned& nloc, unsigned& nx) {
  const unsigned G = gridDim.x * gridDim.y * gridDim.z;
  unsigned sum, cnt, mine, sp = 0u;
  for (;;) {
    sum = 0u; cnt = 0u; mine = 0u;
#pragma unroll
    for (unsigned j = 0; j < 16; ++j) { const unsigned c = xb_ld(&bar[XB_XCNT(j)]); sum += c; cnt += (c > 0u) ? 1u : 0u; mine = (j == x) ? c : mine; }
    if (sum == G) break;
    __builtin_amdgcn_s_sleep(1);
    if ((++sp & 255u) == 0u) { if (xb_ld(&bar[XB_TMO])) break; if (sp > XB_SPIN_CAP) { atomicAdd(&bar[XB_TMO], 1u); break; } }
  }
  nloc = mine > 0u ? mine : 1u; nx = cnt > 0u ? cnt : 1u;
}
__device__ __forceinline__ void xcd_barrier(const XcdBarrier& b) {
  asm volatile("s_waitcnt vmcnt(0)" ::: "memory");
  __syncthreads();
  if (threadIdx.x == 0) {
    unsigned* bar = b.bar;
    __builtin_amdgcn_s_waitcnt(0);
    unsigned nloc = b.st[0], nx = b.st[1];
    if (nloc == 0u) { xcd_barrier_complete(bar, b.x, nloc, nx); b.st[0] = nloc; b.st[1] = nx; }
    const unsigned old = xb_add(&bar[XB_XSUB(b.x)], 1u);
    const unsigned gen = old / nloc;
    if (old + 1u == (gen + 1u) * nloc) {
      __builtin_amdgcn_fence(__ATOMIC_RELEASE, "agent");
      asm volatile("s_waitcnt vmcnt(0)" ::: "memory");
      const unsigned og = xb_add(&bar[XB_TOP], 1u);
      const unsigned tg = og / nx;
      if (og + 1u == (tg + 1u) * nx) xb_add(&bar[XB_TOPGEN], 1u);
      else XB_SPIN(xb_ld(&bar[XB_TOPGEN]) == tg, bar);
      __builtin_amdgcn_fence(__ATOMIC_ACQUIRE, "agent");
      xb_add(&bar[XB_XGEN(b.x)], 1u);
      asm volatile("s_waitcnt vmcnt(0)" ::: "memory");
    } else {
      XB_SPIN(xb_ld(&bar[XB_XGEN(b.x)]) == gen, bar);
      __builtin_amdgcn_fence(__ATOMIC_ACQUIRE, "agent");
      asm volatile("s_waitcnt vmcnt(0)" ::: "memory");
    }
  }
  __syncthreads();
}

template <bool COOP>
__global__ void __launch_bounds__(512) mk_forward(Params p, int ph0, int ph1) {
  __shared__ __attribute__((aligned(1024))) char shm_[LDS_BYTES];
  lchar* shm = (lchar*)shm_;
#ifdef ONLY_PHASE
#define PH_ON(k) ((k) == ONLY_PHASE)
#else
#define PH_ON(k) (ph0 <= (k) && (k) <= ph1)
#endif
  XcdBarrier xb{};
  if (COOP) {
    volatile LAS unsigned* st = (volatile LAS unsigned*)(shm + 131072 + 3584);
    if (threadIdx.x == 0) { st[0] = 0u; st[1] = 0u; st[2] = 0u; st[3] = 0u; }
    __syncthreads();
    xb = xcd_barrier_post((unsigned*)(p.ws + OFF_BAR), st);
    if (ph1 > 1000) cg::this_grid().sync();
  }
#define PH_SYNC(k) do { if (COOP && ph0 <= (k) && (k) < ph1) xcd_barrier(xb); } while (0)
  if (PH_ON(0)) phase0a(p, shm);
#if DBG == 13
  __syncthreads();
  if (PH_ON(0)) phase0a(p, shm);
#endif
  PH_SYNC(0);
  if (PH_ON(1)) rows_phase(p, 0);
#if DBG == 14
  if (PH_ON(1)) rows_phase(p, 0);
#endif
  PH_SYNC(1);
  if (PH_ON(2)) gemm_phase8(shm, (const bf16_t*)((const char*)p.out + OUT_H), DM, 1 << 30, 0, (const bf16_t*)(p.ws + OFF_WIN), DM, INW, Epi8InProj{p});
  if (PH_ON(2)) { __syncthreads(); bias2_items(p, shm); late_transposes(p, shm); }
#if DBG == 11
  __syncthreads();
  if (PH_ON(2)) gemm_phase8(shm, (const bf16_t*)((const char*)p.out + OUT_H), DM, 1 << 30, 0, (const bf16_t*)(p.ws + OFF_WIN), DM, INW, Epi8InProj{p});
#endif
  PH_SYNC(2);
  if (PH_ON(3)) phase2(p, shm);
#if DBG == 12
  __syncthreads();
  if (PH_ON(3)) phase2(p, shm);
#endif
  PH_SYNC(3);
  if (PH_ON(4)) phase3(p, shm);
  PH_SYNC(4);
#if DBG == 16
  if (PH_ON(5)) phase4(p, shm, true);
  __syncthreads();
#endif
  if (PH_ON(5)) phase4(p, shm);
  PH_SYNC(5);
  if (PH_ON(6)) gemm_phase8(shm, (const bf16_t*)(p.ws + OFF_PROJ), INW, 512, 1536, (const bf16_t*)(p.ws + OFF_WOUT), DM, DM, Epi8OutProj{p});
  PH_SYNC(6);
  if (PH_ON(8)) gemm_phase8(shm, (const bf16_t*)(p.ws + OFF_H2), DM, 1 << 30, 0, (const bf16_t*)(p.ws + OFF_W1), DM, DFF, Epi8MlpIn{p});
#if DBG == 10
  __syncthreads();
  if (PH_ON(8)) gemm_phase8(shm, (const bf16_t*)(p.ws + OFF_H2), DM, 1 << 30, 0, (const bf16_t*)(p.ws + OFF_W1), DM, DFF, Epi8MlpIn{p});
#endif
  PH_SYNC(8);
  if (PH_ON(9)) gemm_phase8(shm, (const bf16_t*)(p.ws + OFF_PROJ), DFF, 1 << 30, 0, (const bf16_t*)(p.ws + OFF_W2), DFF, DM, Epi8MlpOut{p});
  PH_SYNC(9);
  if (PH_ON(10)) rows_phase(p, 2);
}

extern "C" void kernel_launch(void* const* d_in, const int* in_sizes, int n_in, void* d_out, int out_size, void* d_ws, size_t ws_size,
                              hipStream_t stream) {
  Params p{};
  p.x_prompt = (const float*)d_in[0]; p.x_sample = (const float*)d_in[1]; p.c_prompt = (const float*)d_in[2]; p.c_sample = (const float*)d_in[3];
  p.ada_w = (const float*)d_in[4]; p.ada_b = (const float*)d_in[5]; p.norm_mix = (const float*)d_in[6]; p.w_in = (const float*)d_in[7];
  p.w_fnet = (const float*)d_in[8]; p.w_out = (const float*)d_in[9]; p.norm_mlp = (const float*)d_in[10]; p.w_mlp_in = (const float*)d_in[11];
  p.w_mlp_out = (const float*)d_in[12]; p.norm_final = (const float*)d_in[13];
  p.out = (float*)d_out; p.ws = (char*)d_ws;
  if (ws_size < WS_END) { fprintf(stderr, "workspace too small: %zu < %zu\n", ws_size, (size_t)WS_END); return; }
#if MK_COOP
  static int grid_blocks = 0;
  if (!grid_blocks) {
    int dev = 0, cus = 0, per_cu = 0;
    hipGetDevice(&dev);
    hipDeviceGetAttribute(&cus, hipDeviceAttributeMultiprocessorCount, dev);
    hipOccupancyMaxActiveBlocksPerMultiprocessor(&per_cu, mk_forward<true>, 512, 0);
    if (per_cu > 1) per_cu = 1;
    grid_blocks = cus * per_cu;
  }
  hipMemsetAsync((char*)d_ws + OFF_BAR, 0, 3456 * 4, stream);
  int ph0 = 0, ph1 = 10;
  void* args[] = {&p, &ph0, &ph1};
  hipError_t e = hipLaunchCooperativeKernel((void*)mk_forward<true>, dim3(grid_blocks), dim3(512), args, 0, stream);
  if (e != hipSuccess) fprintf(stderr, "cooperative launch failed: %s (grid %d)\n", hipGetErrorString(e), grid_blocks);
#else
  for (int ph = 0; ph <= 10; ++ph) mk_forward<false><<<256, 512, 0, stream>>>(p, ph, ph);
#endif
}
```
